# Optimizing an MI355X kernel written in HIP

```python
import math
import jax
import jax.numpy as jnp
from jax import lax
import numpy as np

D_MODEL = 1024
BATCH = 4
SEQ = 4096
DEPTH = 1

CHUNK = 64
PLE_DIM = 256
D_FF = 2816
NORM_EPS = 1e-6

S5_WIDTH = 512
S5_GROUP = 16
S5_GROUPS = S5_WIDTH // S5_GROUP
S5_STATE = 64
S5_DT_MIN = 1e-3
S5_DT_MAX = 1e-1

HG_HEADS = 8
HG_EXPAND = 128
HG_WIDTH = HG_HEADS * HG_EXPAND

N_BRANCHES = 2
IN_SPLITS = (S5_WIDTH, HG_WIDTH, HG_WIDTH, HG_WIDTH, HG_WIDTH, D_MODEL, D_MODEL)
IN_COLS = S5_WIDTH + 4 * HG_WIDTH + N_BRANCHES * D_MODEL

kernel_name = 'hybrid_s5_hgrn2_macaron_block'


def rmsnorm(x, gain):
    xf = x.astype(jnp.float32)
    y = xf * lax.rsqrt(jnp.mean(jnp.square(xf), axis=-1, keepdims=True) + NORM_EPS)
    return (y * gain.astype(jnp.float32)).astype(x.dtype)


def swiglu(x, w_gate, w_up, w_down):
    return (jax.nn.silu(x @ w_gate) * (x @ w_up)) @ w_down


def split_columns(proj):
    pieces, start = [], 0
    for width in IN_SPLITS:
        pieces.append(proj[..., start:start + width])
        start += width
    return pieces


def s5_mixer(u, lam_re, lam_im, log_dt, b_re, b_im, c_re, c_im, d_skip):
    f32 = jnp.float32
    bsz, seqlen, _ = u.shape
    uf = u.astype(f32).reshape(bsz, seqlen, S5_GROUPS, S5_GROUP)
    lam = lax.complex(lam_re.astype(f32), lam_im.astype(f32))
    dt = jnp.exp(log_dt.astype(f32))[:, None]
    lam_bar = jnp.exp(lam * dt)
    b = lax.complex(b_re.astype(f32), b_im.astype(f32))
    b_bar = ((lam_bar - 1.0) / lam)[..., None] * b
    bu = jnp.einsum('blgh,gph->blgp', uf, b_bar)
    a = jnp.broadcast_to(lam_bar, (1, seqlen, S5_GROUPS, S5_STATE))

    def combine(left, right):
        a_l, b_l = left
        a_r, b_r = right
        return a_r * a_l, a_r * b_l + b_r

    _, states = lax.associative_scan(combine, (a, bu), axis=1)
    c = lax.complex(c_re.astype(f32), c_im.astype(f32))
    y = jnp.einsum('blgp,ghp->blgh', states, c).real
    y = y + d_skip.astype(f32).reshape(S5_GROUPS, S5_GROUP) * uf
    return y.reshape(bsz, seqlen, S5_WIDTH)


def hgrn2_mixer(q, f_logit, i_in, lower_bound):
    f32 = jnp.float32
    bsz, seqlen, _ = q.shape
    n_chunks = seqlen // CHUNK
    lb = lower_bound.astype(f32)
    z = f_logit.astype(f32)
    log_f = jnp.log(lb + (1.0 - lb) * jax.nn.sigmoid(z))
    k = (1.0 - lb) * jax.nn.sigmoid(-z)

    def to_chunks(t):
        return t.reshape(bsz, n_chunks, CHUNK, HG_HEADS, HG_EXPAND).transpose(1, 0, 3, 2, 4)

    qc = to_chunks(q.astype(f32) * (HG_EXPAND ** -0.5))
    kc = to_chunks(k)
    vc = to_chunks(i_in.astype(f32))
    gc = to_chunks(log_f)
    causal = jnp.tril(jnp.ones((CHUNK, CHUNK), dtype=bool))[:, :, None]

    def step(state, inp):
        q_c, k_c, v_c, g_c = inp
        gcum = jnp.cumsum(g_c, axis=2)
        o_inter = jnp.einsum('bhck,bhkv->bhcv', q_c * jnp.exp(gcum), state)
        diff = gcum[:, :, :, None, :] - gcum[:, :, None, :, :]
        decay = jnp.exp(jnp.where(causal, diff, -jnp.inf))
        scores = jnp.einsum('bhtk,bhsk,bhtsk->bhts', q_c, k_c, decay)
        o_intra = jnp.einsum('bhts,bhsv->bhtv', scores, v_c)
        g_last = gcum[:, :, -1:, :]
        k_dec = k_c * jnp.exp(g_last - gcum)
        new_state = (jnp.exp(g_last[:, :, 0, :])[..., None] * state
                     + jnp.einsum('bhsk,bhsv->bhkv', k_dec, v_c))
        return new_state, o_inter + o_intra

    s0 = jnp.zeros((bsz, HG_HEADS, HG_EXPAND, HG_EXPAND), f32)
    _, o = lax.scan(step, s0, (qc, kc, vc, gc))
    return o.transpose(1, 0, 3, 2, 4).reshape(bsz, seqlen, HG_WIDTH)


def head_rmsnorm(o, gain):
    bsz, seqlen, _ = o.shape
    oh = o.reshape(bsz, seqlen, HG_HEADS, HG_EXPAND)
    return rmsnorm(oh, gain.reshape(HG_HEADS, HG_EXPAND)).reshape(bsz, seqlen, HG_WIDTH)


def setup_inputs(seed: int = 0) -> dict:
    key = jax.random.key(seed)
    ks = jax.random.split(key, 40)
    f32 = jnp.float32

    def nrm(k, shape, scale):
        return jax.random.normal(k, shape, f32) * scale

    def gain(k, shape):
        return 1.0 + 0.01 * jax.random.normal(k, shape, f32)

    n_idx = jnp.arange(S5_STATE, dtype=f32)
    return {
        'x': nrm(ks[0], (BATCH, SEQ, D_MODEL), 1.0),
        'p': nrm(ks[1], (DEPTH, BATCH, SEQ, PLE_DIM), 1.0),
        'ffn1_norm': gain(ks[2], (DEPTH, D_MODEL)),
        'ffn1_w_gate': nrm(ks[3], (DEPTH, D_MODEL, D_FF), D_MODEL ** -0.5),
        'ffn1_w_up': nrm(ks[4], (DEPTH, D_MODEL, D_FF), D_MODEL ** -0.5),
        'ffn1_w_down': nrm(ks[5], (DEPTH, D_FF, D_MODEL), D_FF ** -0.5),
        'mix_norm': gain(ks[6], (DEPTH, D_MODEL)),
        'w_in': nrm(ks[7], (DEPTH, D_MODEL, IN_COLS), D_MODEL ** -0.5),
        's5_lam_re': -0.5 + 0.01 * jax.random.normal(ks[8], (DEPTH, S5_GROUPS, S5_STATE), f32),
        's5_lam_im': math.pi * n_idx + 0.01 * jax.random.normal(ks[9], (DEPTH, S5_GROUPS, S5_STATE), f32),
        's5_log_dt': jax.random.uniform(ks[10], (DEPTH, S5_GROUPS), f32,
                                        minval=math.log(S5_DT_MIN), maxval=math.log(S5_DT_MAX)),
        's5_b_re': nrm(ks[11], (DEPTH, S5_GROUPS, S5_STATE, S5_GROUP), (2.0 * S5_GROUP) ** -0.5),
        's5_b_im': nrm(ks[12], (DEPTH, S5_GROUPS, S5_STATE, S5_GROUP), (2.0 * S5_GROUP) ** -0.5),
        's5_c_re': nrm(ks[13], (DEPTH, S5_GROUPS, S5_GROUP, S5_STATE), 0.5),
        's5_c_im': nrm(ks[14], (DEPTH, S5_GROUPS, S5_GROUP, S5_STATE), 0.5),
        's5_d': nrm(ks[15], (DEPTH, S5_WIDTH), 1.0),
        's5_glu_val': nrm(ks[16], (DEPTH, S5_WIDTH, D_MODEL), S5_WIDTH ** -0.5),
        's5_glu_gate': nrm(ks[17], (DEPTH, S5_WIDTH, D_MODEL), S5_WIDTH ** -0.5),
        'hg_lower_bound': nrm(ks[18], (DEPTH + 1, HG_WIDTH), 0.1),
        'hg_out_norm': gain(ks[19], (DEPTH, HG_WIDTH)),
        'hg_w_out': nrm(ks[20], (DEPTH, HG_WIDTH, D_MODEL), HG_WIDTH ** -0.5),
        'w_merge_out': nrm(ks[21], (DEPTH, D_MODEL, D_MODEL), D_MODEL ** -0.5),
        'ffn2_norm': gain(ks[22], (DEPTH, D_MODEL)),
        'ffn2_w_gate': nrm(ks[23], (DEPTH, D_MODEL, D_FF), D_MODEL ** -0.5),
        'ffn2_w_up': nrm(ks[24], (DEPTH, D_MODEL, D_FF), D_MODEL ** -0.5),
        'ffn2_w_down': nrm(ks[25], (DEPTH, D_FF, D_MODEL), D_FF ** -0.5),
        'ple_norm': gain(ks[26], (DEPTH, D_MODEL)),
        'ple_w_gate': nrm(ks[27], (DEPTH, D_MODEL, D_MODEL), D_MODEL ** -0.5),
        'ple_w_proj': nrm(ks[28], (DEPTH, PLE_DIM, D_MODEL), PLE_DIM ** -0.5),
        'final_norm': gain(ks[29], (D_MODEL,)),
    }


def reference(x, p, ffn1_norm, ffn1_w_gate, ffn1_w_up, ffn1_w_down, mix_norm, w_in,
              s5_lam_re, s5_lam_im, s5_log_dt, s5_b_re, s5_b_im, s5_c_re, s5_c_im, s5_d,
              s5_glu_val, s5_glu_gate, hg_lower_bound, hg_out_norm, hg_w_out, w_merge_out,
              ffn2_norm, ffn2_w_gate, ffn2_w_up, ffn2_w_down, ple_norm, ple_w_gate,
              ple_w_proj, final_norm):
    lower_bounds = jnp.cumsum(jax.nn.softmax(hg_lower_bound.astype(jnp.float32), axis=0), axis=0)
    h = x
    for layer in range(DEPTH):
        h = h + 0.5 * swiglu(rmsnorm(h, ffn1_norm[layer]),
                             ffn1_w_gate[layer], ffn1_w_up[layer], ffn1_w_down[layer])

        u = rmsnorm(h, mix_norm[layer])
        s5_in, hg_q, hg_f, hg_i, hg_g, gate_a, gate_b = split_columns(u @ w_in[layer])

        y_s5 = s5_mixer(s5_in, s5_lam_re[layer], s5_lam_im[layer], s5_log_dt[layer],
                        s5_b_re[layer], s5_b_im[layer], s5_c_re[layer], s5_c_im[layer],
                        s5_d[layer])
        y_s5 = jax.nn.gelu(y_s5).astype(h.dtype)
        y_a = (y_s5 @ s5_glu_val[layer]) * jax.nn.sigmoid(y_s5 @ s5_glu_gate[layer])

        o = hgrn2_mixer(hg_q, hg_f, hg_i, lower_bounds[layer]).astype(h.dtype)
        o = head_rmsnorm(o, hg_out_norm[layer]) * jax.nn.silu(hg_g)
        y_b = o @ hg_w_out[layer]

        mixed = jax.nn.sigmoid(gate_a) * y_a + jax.nn.sigmoid(gate_b) * y_b
        h = h + mixed @ w_merge_out[layer]

        h = h + 0.5 * swiglu(rmsnorm(h, ffn2_norm[layer]),
                             ffn2_w_gate[layer], ffn2_w_up[layer], ffn2_w_down[layer])

        ple_gate = jax.nn.sigmoid(rmsnorm(h, ple_norm[layer]) @ ple_w_gate[layer])
        h = h + ple_gate * (p[layer] @ ple_w_proj[layer])
    return rmsnorm(h, final_norm)
```

```cpp
#include <hip/hip_runtime.h>
#include <cstdio>
#include <cstdint>
__device__ __forceinline__ int hw_lane() { int l; asm volatile("v_mbcnt_lo_u32_b32 %0, -1, 0\n\tv_mbcnt_hi_u32_b32 %0, -1, %0" : "=v"(l)); return l; }
namespace pg8 {
#define PG8_LAS __attribute__((address_space(3)))
typedef unsigned short bf16_t;
typedef short bf16x8 __attribute__((ext_vector_type(8)));
typedef float f32x4 __attribute__((ext_vector_type(4)));
typedef unsigned u32x4 __attribute__((ext_vector_type(4)));
constexpr int BM = 256, BK = 64, HALF = 128, HTB = HALF * BK * 2  , STAGE_BYTES = 8 * HTB, NXCD = 8, WGM = 8;

__host__ __device__ __forceinline__ int lds_byte(int r, int c) { const int st = (r >> 4) * 2 + (c >> 5), rr = r & 15, cc = c & 31, ob = rr * 64 + cc * 2; return st * 1024 + (ob ^ (((ob >> 9) & 1) << 5)); }
__host__ __device__ __forceinline__ void stage_rc(int b, int& R, int& C) { const int st = b / 1024, sb = b % 1024, swz = sb ^ (((sb >> 9) & 1) << 5); R = (st >> 1) * 16 + swz / 64; C = (st & 1) * 32 + (swz % 64) / 2; }
__host__ __device__ __forceinline__ int perm32(int rho) { const int n = rho >> 4, i = rho & 15; return 8 * (i >> 2) + 4 * n + (i & 3); }

struct Unit { int pm, pn; };
struct Gemm { const bf16_t* A; const bf16_t* Bt; int M, N, K; };

struct StaticOrder {
    int nM, nN, nwg, G, c;
    __host__ __device__ void init(int M, int N, int G_, int c_) { nM = M / BM; nN = N / BM; nwg = nM * nN; G = G_; c = c_; }
    __host__ __device__ bool next(int i, Unit& u) const {
        const long L = (long)i * G + c; if (L >= nwg) return false;
        int wgid = (int)L; { const int q = nwg / NXCD, r = nwg % NXCD, xcd = wgid % NXCD, off = wgid / NXCD; wgid = (xcd < r ? xcd * (q + 1) : r * (q + 1) + (xcd - r) * q) + off; }
        const int nig = WGM * nN, gid = wgid / nig, fm = gid * WGM, gsz = (nM - fm) < WGM ? (nM - fm) : WGM;
        u.pm = fm + ((wgid % nig) % gsz); u.pn = (wgid % nig) / gsz; return true;
    }
    __device__ __forceinline__ void a_ready(const Unit&) const {}
    __device__ __forceinline__ void done(const Unit&) const {}
};

__device__ __forceinline__ unsigned cvt_pk_bf16(float lo, float hi) { unsigned r; asm volatile("v_cvt_pk_bf16_f32 %0, %1, %2" : "=v"(r) : "v"(lo), "v"(hi)); return r; }
typedef float f32x2 __attribute__((ext_vector_type(2)));
template <class Epi, class Sched, bool ALIGN_EPI = false, bool SP2 = false>
__device__ __forceinline__ void gemm_phase(PG8_LAS unsigned char* lds, const Gemm g, const Sched& S, const Epi& E, const int wid) {
    const int lane = hw_lane(), tid = wid * 64 + lane, wr = wid >> 2, wc = wid & 3, fr = lane & 15, fq = lane >> 4;
    const int K = g.K, nt = K / BK;
    unsigned voffA[2], voffB[2];
#pragma unroll
    for (int i = 0; i < 2; ++i) { int R, C; stage_rc(tid * 16 + i * 8192, R, C); const int Rb = Epi::PERM ? ((R & ~31) + perm32(R & 31)) : R;
        voffA[i] = (unsigned)(R * K + C) * 2u; voffB[i] = (unsigned)(Rb * K + C) * 2u; }
    const size_t kstep = (size_t)(BK * 2);
    const size_t hstep = (size_t)HALF * K * 2;
    const size_t tstep = 2 * hstep;
    const unsigned ldsw = (unsigned)wid * 1024u;
    const int aoff = lds_byte(wr * 64 + fr, fq * 8), boff = lds_byte(wc * 32 + fr, fq * 8);
#define PG8_SA(b, h) (((b) * 2 + (h)) * HTB)
#define PG8_SB(b, h) ((4 + (b) * 2 + (h)) * HTB)
#define PG8_STAGE(bufoff, gbase, voff) do { _Pragma("unroll") for (int _i = 0; _i < 2; ++_i) \
        __builtin_amdgcn_global_load_lds((const unsigned*)((const char*)(gbase) + (voff)[_i]), (PG8_LAS unsigned*)(lds + (bufoff) + ldsw + _i * 8192), 16, 0, 0); } while (0)
#define PG8_LDA(dst, b, h) do { _Pragma("unroll") for (int m = 0; m < 4; ++m) _Pragma("unroll") for (int k = 0; k < 2; ++k) dst[m][k] = *(const PG8_LAS bf16x8*)(lds + PG8_SA(b, h) + aoff + m * 2048 + k * 1024); } while (0)
#define PG8_LDB(dst, b, h) do { _Pragma("unroll") for (int n = 0; n < 2; ++n) _Pragma("unroll") for (int k = 0; k < 2; ++k) dst[n][k] = *(const PG8_LAS bf16x8*)(lds + PG8_SB(b, h) + boff + n * 2048 + k * 1024); } while (0)
#define PG8_MMA(ai, bj, At, Bt) do { __builtin_amdgcn_s_setprio(1); _Pragma("unroll") for (int m = 0; m < 4; ++m) _Pragma("unroll") for (int n = 0; n < 2; ++n) _Pragma("unroll") for (int k = 0; k < 2; ++k) \
        acc[ai][bj][m][n] = __builtin_amdgcn_mfma_f32_16x16x32_bf16(Bt[n][k], At[m][k], acc[ai][bj][m][n], 0, 0, 0); __builtin_amdgcn_s_setprio(0); } while (0)
#define PG8_WAIT_V(n) asm volatile("s_waitcnt vmcnt(" #n ")" ::: "memory")
#define PG8_WAIT_L(n) asm volatile("s_waitcnt lgkmcnt(" #n ")" ::: "memory")
#define PG8_BAR __builtin_amdgcn_s_barrier()
#define PG8_SCHED __builtin_amdgcn_sched_barrier(0)
    Unit cur, nxt; int ui = 0;
    if (!S.next(0, cur)) return;
    f32x4 acc[2][2][4][2];
#pragma unroll
    for (int a = 0; a < 2; ++a)
#pragma unroll
        for (int b = 0; b < 2; ++b)
#pragma unroll
            for (int m = 0; m < 4; ++m)
#pragma unroll
                for (int n = 0; n < 2; ++n) acc[a][b][m][n] = (f32x4){0.f, 0.f, 0.f, 0.f};
    bf16x8 At[4][2], B0[2][2], B1[2][2];
    const char* cA = (const char*)g.A + (size_t)cur.pm * tstep; const char* cB = (const char*)g.Bt + (size_t)cur.pn * tstep;
    S.a_ready(cur);
    if constexpr (SP2) {
        PG8_STAGE(PG8_SB(0, 0), cB, voffB); PG8_STAGE(PG8_SB(0, 1), cB + hstep, voffB); PG8_STAGE(PG8_SA(0, 0), cA, voffA); PG8_STAGE(PG8_SA(0, 1), cA + hstep, voffA);
        if (wr == 1) PG8_BAR;
        PG8_WAIT_V(2); PG8_BAR;
        PG8_STAGE(PG8_SB(1, 0), cB + kstep, voffB); PG8_STAGE(PG8_SA(1, 0), cA + kstep, voffA); PG8_STAGE(PG8_SB(1, 1), cB + hstep + kstep, voffB);
        PG8_WAIT_V(6); PG8_BAR;
    } else {
        PG8_STAGE(PG8_SB(0, 0), cB, voffB); PG8_STAGE(PG8_SA(0, 0), cA, voffA); PG8_STAGE(PG8_SB(0, 1), cB + hstep, voffB); PG8_STAGE(PG8_SA(0, 1), cA + hstep, voffA);
        if (wr == 1) PG8_BAR;
        PG8_WAIT_V(4); PG8_BAR;
        PG8_STAGE(PG8_SB(1, 0), cB + kstep, voffB); PG8_STAGE(PG8_SA(1, 0), cA + kstep, voffA); PG8_STAGE(PG8_SB(1, 1), cB + hstep + kstep, voffB);
        PG8_WAIT_V(6); PG8_BAR;
    }
    for (;;) {
        const bool has_next = S.next(ui + 1, nxt);
        const char* nA = has_next ? (const char*)g.A + (size_t)nxt.pm * tstep : cA; const char* nB = has_next ? (const char*)g.Bt + (size_t)nxt.pn * tstep : cB;
        for (int t = 0; t < nt; t += 2) {
            const bool last = (t == nt - 2);
            const char* a1 = cA + (size_t)(t + 1) * kstep;
            const char* a2 = last ? nA : cA + (size_t)(t + 2) * kstep; const char* b2 = last ? nB : cB + (size_t)(t + 2) * kstep;
            const char* a3 = a2 + kstep; const char* b3 = b2 + kstep;
            if (last && has_next) S.a_ready(nxt);
            if constexpr (SP2) {
            PG8_LDB(B0, 0, 0); PG8_LDB(B1, 0, 1); PG8_SCHED; PG8_LDA(At, 0, 0); PG8_STAGE(PG8_SA(1, 1), a1 + hstep, voffA);
            PG8_WAIT_V(8); PG8_WAIT_L(0); PG8_BAR; PG8_MMA(0, 0, At, B0); PG8_MMA(0, 1, At, B1); PG8_BAR; PG8_SCHED;
            PG8_LDA(At, 0, 1); PG8_STAGE(PG8_SB(0, 0), b2, voffB); PG8_STAGE(PG8_SB(0, 1), b2 + hstep, voffB); PG8_STAGE(PG8_SA(0, 0), a2, voffA);
            PG8_WAIT_V(8); PG8_WAIT_L(0); PG8_BAR; PG8_MMA(1, 0, At, B0); PG8_MMA(1, 1, At, B1); PG8_BAR; PG8_SCHED;
            PG8_LDB(B0, 1, 0); PG8_LDB(B1, 1, 1); PG8_SCHED; PG8_LDA(At, 1, 0); PG8_STAGE(PG8_SA(0, 1), a2 + hstep, voffA);
            PG8_WAIT_V(8); PG8_WAIT_L(0); PG8_BAR; PG8_MMA(0, 0, At, B0); PG8_MMA(0, 1, At, B1); PG8_BAR; PG8_SCHED;
            PG8_LDA(At, 1, 1); PG8_STAGE(PG8_SB(1, 0), b3, voffB); PG8_STAGE(PG8_SB(1, 1), b3 + hstep, voffB); PG8_STAGE(PG8_SA(1, 0), a3, voffA);
            PG8_WAIT_V(8); PG8_WAIT_L(0); PG8_BAR; PG8_MMA(1, 0, At, B0); PG8_MMA(1, 1, At, B1); PG8_BAR; PG8_SCHED;
            } else {
            PG8_LDB(B0, 0, 0); PG8_SCHED; PG8_LDA(At, 0, 0); PG8_STAGE(PG8_SA(1, 1), a1 + hstep, voffA);
            PG8_WAIT_L(8); PG8_BAR; PG8_WAIT_L(0); PG8_MMA(0, 0, At, B0); PG8_BAR; PG8_SCHED;
            PG8_LDB(B1, 0, 1); PG8_STAGE(PG8_SB(0, 0), b2, voffB);
            PG8_BAR; PG8_WAIT_L(0); PG8_MMA(0, 1, At, B1); PG8_BAR;
            PG8_LDA(At, 0, 1); PG8_STAGE(PG8_SA(0, 0), a2, voffA);
            PG8_BAR; PG8_WAIT_L(0); PG8_MMA(1, 0, At, B0); PG8_BAR; PG8_SCHED;
            PG8_STAGE(PG8_SB(0, 1), b2 + hstep, voffB);
            PG8_WAIT_V(6); PG8_BAR; PG8_MMA(1, 1, At, B1); PG8_BAR;
            PG8_LDB(B0, 1, 0); PG8_SCHED; PG8_LDA(At, 1, 0); PG8_STAGE(PG8_SA(0, 1), a2 + hstep, voffA);
            PG8_WAIT_L(8); PG8_BAR; PG8_WAIT_L(0); PG8_MMA(0, 0, At, B0); PG8_BAR; PG8_SCHED;
            PG8_LDB(B1, 1, 1); PG8_STAGE(PG8_SB(1, 0), b3, voffB);
            PG8_BAR; PG8_WAIT_L(0); PG8_MMA(0, 1, At, B1); PG8_BAR;
            PG8_LDA(At, 1, 1); PG8_STAGE(PG8_SA(1, 0), a3, voffA);
            PG8_BAR; PG8_WAIT_L(0); PG8_MMA(1, 0, At, B0); PG8_BAR; PG8_SCHED;
            PG8_STAGE(PG8_SB(1, 1), b3 + hstep, voffB);
            PG8_WAIT_V(6); PG8_BAR; PG8_MMA(1, 1, At, B1); PG8_BAR;
            }
        }
        if constexpr (ALIGN_EPI) { if (wr == 0) PG8_BAR; }
        if constexpr (!Epi::AFTER_DRAIN) { E(acc, cur, wr, wc, fr, fq); S.done(cur); }
        if (!has_next) break;
#pragma unroll
        for (int a = 0; a < 2; ++a)
#pragma unroll
            for (int b = 0; b < 2; ++b)
#pragma unroll
                for (int m = 0; m < 4; ++m)
#pragma unroll
                    for (int n = 0; n < 2; ++n) acc[a][b][m][n] = (f32x4){0.f, 0.f, 0.f, 0.f};
        cur = nxt; cA = nA; cB = nB; ++ui;
        if constexpr (ALIGN_EPI) { if (wr == 1) PG8_BAR; }
    }
    PG8_WAIT_V(0);
    if constexpr (!ALIGN_EPI) { if (wr == 0) PG8_BAR; }
    PG8_BAR;
    if constexpr (Epi::AFTER_DRAIN) { E.fused(acc, cur, wr, wc, fr, fq, lds, wid, lane); S.done(cur); }
#undef PG8_SA
#undef PG8_SB
#undef PG8_STAGE
#undef PG8_LDA
#undef PG8_LDB
#undef PG8_MMA
#undef PG8_WAIT_V
#undef PG8_WAIT_L
#undef PG8_BAR
#undef PG8_SCHED
}

constexpr int M_TOK = 16384, DM = 1024, FF = 2816, NIN = 6656, SEQ = 4096, NBATCH = 4;
constexpr int S5T = 32, S5NC = SEQ / S5T  , S5ROWS = NBATCH * S5NC  ;

struct BatchOrder {
    int nMg, nNg, per, total, G, c;
    __host__ __device__ void init(int ng, int nMg_, int nNg_, int G_, int c_) { nMg = nMg_; nNg = nNg_; per = nMg_ * nNg_; total = ng * per; G = G_; c = c_; }
    __host__ __device__ bool next(int i, Unit& u) const { const int L = i * G + c; if (L >= total) return false; const int g = L / per, r = L % per; u.pm = g * nMg + (r % nMg); u.pn = g * nNg + (r / nMg); return true; }
    __device__ __forceinline__ void a_ready(const Unit&) const {}
    __device__ __forceinline__ void done(const Unit&) const {}
};

typedef unsigned u32x2 __attribute__((ext_vector_type(2)));
__device__ __forceinline__ float sigm(float z) { return __builtin_amdgcn_rcpf(1.f + __builtin_amdgcn_exp2f(-1.44269504f * z)); }
__device__ __forceinline__ float bf_lo(unsigned w) { return __builtin_bit_cast(float, w << 16); }
__device__ __forceinline__ float bf_hi(unsigned w) { return __builtin_bit_cast(float, w & 0xffff0000u); }
__device__ __forceinline__ u32x4 pack8(const float (&v)[8]) { u32x4 w; w.x = cvt_pk_bf16(v[0], v[1]); w.y = cvt_pk_bf16(v[2], v[3]); w.z = cvt_pk_bf16(v[4], v[5]); w.w = cvt_pk_bf16(v[6], v[7]); return w; }
__device__ __forceinline__ void unpack8(const u32x4 w, float (&v)[8]) { v[0] = bf_lo(w.x); v[1] = bf_hi(w.x); v[2] = bf_lo(w.y); v[3] = bf_hi(w.y); v[4] = bf_lo(w.z); v[5] = bf_hi(w.z); v[6] = bf_lo(w.w); v[7] = bf_hi(w.w); }
__device__ __forceinline__ void row_scales(const float* RS, int row0, float (&r)[2][4]) {
#pragma unroll
    for (int ai = 0; ai < 2; ++ai)
#pragma unroll
        for (int m = 0; m < 4; ++m) { const f32x4 p = *(const f32x4*)(RS + (size_t)(row0 + ai * HALF + m * 16) * 4); r[ai][m] = __builtin_amdgcn_rsqf(((p.x + p.y) + (p.z + p.w)) * (1.0f / 1024.0f) + 1e-6f); }
}

struct EpiSwiglu {
    static constexpr bool PERM = true, AFTER_DRAIN = false;
    bf16_t* HID; const float* RS;
    __device__ __forceinline__ void operator()(const f32x4 (&acc)[2][2][4][2], const Unit& u, int wr, int wc, int fr, int fq) const {
        const int row0 = u.pm * BM + wr * 64 + fr, ch0 = u.pn * HALF + wc * 32 + 8 * fq;
        float r[2][4]; row_scales(RS, row0, r);
#pragma unroll
        for (int ai = 0; ai < 2; ++ai)
#pragma unroll
            for (int m = 0; m < 4; ++m) { const float rr = r[ai][m]; float h[8];
#pragma unroll
                for (int n = 0; n < 2; ++n)
#pragma unroll
                    for (int e = 0; e < 4; ++e) { const float g = acc[ai][0][m][n][e] * rr, up = acc[ai][1][m][n][e] * rr; h[4 * n + e] = g * sigm(g) * up; }
                *(u32x4*)(HID + (size_t)(row0 + ai * HALF + m * 16) * FF + ch0) = pack8(h); }
    }
};

struct EpiResid {
    static constexpr bool PERM = false, AFTER_DRAIN = true;
    const float* res; float* H; bf16_t* XB; float* RSout;
    __device__ __forceinline__ void fused(f32x4 (&acc)[2][2][4][2], const Unit& u, int wr, int wc, int fr, int fq, PG8_LAS unsigned char* lds, int wid, int lane) const {
        PG8_LAS float* PS = (PG8_LAS float*)lds;
        const int col0 = u.pn * BM + wc * 32 + 4 * fq;
#pragma unroll
        for (int ai = 0; ai < 2; ++ai)
#pragma unroll
            for (int m = 0; m < 4; ++m) { const int rl = ai * HALF + wr * 64 + m * 16 + fr; const size_t off = (size_t)(u.pm * BM + rl) * DM + col0; float s = 0.f;
#pragma unroll
                for (int bj = 0; bj < 2; ++bj)
#pragma unroll
                    for (int n = 0; n < 2; ++n) { const f32x4 b = *(const f32x4*)(res + off + bj * HALF + n * 16); const f32x4 v = b + acc[ai][bj][m][n];
                        *(f32x4*)(H + off + bj * HALF + n * 16) = v; u32x2 w; w.x = cvt_pk_bf16(v[0], v[1]); w.y = cvt_pk_bf16(v[2], v[3]); *(u32x2*)(XB + off + bj * HALF + n * 16) = w;
                        s += (v[0] * v[0] + v[1] * v[1]) + (v[2] * v[2] + v[3] * v[3]); }
                s += __shfl_xor(s, 16); s += __shfl_xor(s, 32);
                if (fq == 0) PS[rl * 4 + wc] = s; }
        asm volatile("s_waitcnt lgkmcnt(0)" ::: "memory"); __builtin_amdgcn_s_barrier(); asm volatile("" ::: "memory");
        const int tid = wid * 64 + lane;
        if (tid < 256) { const f32x4 p = *(const PG8_LAS f32x4*)(PS + tid * 4); RSout[(size_t)(u.pm * BM + tid) * 4 + u.pn] = (p.x + p.y) + (p.z + p.w); }
    }
};

struct EpiPle {
    static constexpr bool PERM = false, AFTER_DRAIN = true;
    float* H; const bf16_t* PP; const float* RS; float* RSout;
    __device__ __forceinline__ void fused(f32x4 (&acc)[2][2][4][2], const Unit& u, int wr, int wc, int fr, int fq, PG8_LAS unsigned char* lds, int wid, int lane) const {
        PG8_LAS float* PS = (PG8_LAS float*)lds;
        const int col0 = u.pn * BM + wc * 32 + 4 * fq;
        float r[2][4]; row_scales(RS, u.pm * BM + wr * 64 + fr, r);
#pragma unroll
        for (int ai = 0; ai < 2; ++ai)
#pragma unroll
            for (int m = 0; m < 4; ++m) { const int rl = ai * HALF + wr * 64 + m * 16 + fr; const size_t off = (size_t)(u.pm * BM + rl) * DM + col0; float s = 0.f; const float rr = r[ai][m];
#pragma unroll
                for (int bj = 0; bj < 2; ++bj)
#pragma unroll
                    for (int n = 0; n < 2; ++n) { const f32x4 b = *(const f32x4*)(H + off + bj * HALF + n * 16); const u32x2 pw = *(const u32x2*)(PP + off + bj * HALF + n * 16); const f32x4 a = acc[ai][bj][m][n];
                        f32x4 v; v[0] = b[0] + sigm(a[0] * rr) * bf_lo(pw.x); v[1] = b[1] + sigm(a[1] * rr) * bf_hi(pw.x); v[2] = b[2] + sigm(a[2] * rr) * bf_lo(pw.y); v[3] = b[3] + sigm(a[3] * rr) * bf_hi(pw.y);
                        *(f32x4*)(H + off + bj * HALF + n * 16) = v; s += (v[0] * v[0] + v[1] * v[1]) + (v[2] * v[2] + v[3] * v[3]); }
                s += __shfl_xor(s, 16); s += __shfl_xor(s, 32);
                if (fq == 0) PS[rl * 4 + wc] = s; }
        asm volatile("s_waitcnt lgkmcnt(0)" ::: "memory"); __builtin_amdgcn_s_barrier(); asm volatile("" ::: "memory");
        const int tid = wid * 64 + lane;
        if (tid < 256) { const f32x4 p = *(const PG8_LAS f32x4*)(PS + tid * 4); RSout[(size_t)(u.pm * BM + tid) * 4 + u.pn] = (p.x + p.y) + (p.z + p.w); }
    }
};

struct EpiProj {
    static constexpr bool PERM = true, AFTER_DRAIN = false;
    int pn_off; const float* RS; bf16_t* S5IN; bf16_t* Q; unsigned short* G16; bf16_t* I; bf16_t* O; const float* RINV; const float* hg_gain; bf16_t* GA; bf16_t* GB; const float* LB;
    __device__ __forceinline__ void operator()(const f32x4 (&acc)[2][2][4][2], const Unit& u, int wr, int wc, int fr, int fq) const {
        const int pnabs = u.pn + pn_off, row0 = u.pm * BM + wr * 64 + fr;
        const int kind = pnabs < 2 ? 0 : ((pnabs - 2) >> 2) + 1;
        const int cb = (kind == 0 ? pnabs * BM : ((pnabs - 2) & 3) * BM) + wc * 32 + 8 * fq;
        float r[2][4]; row_scales(RS, row0, r);
#pragma unroll
        for (int ai = 0; ai < 2; ++ai)
#pragma unroll
            for (int m = 0; m < 4; ++m) { const float rr = r[ai][m]; const int row = row0 + ai * HALF + m * 16;
#pragma unroll
                for (int bj = 0; bj < 2; ++bj) { const int c = cb + bj * HALF; float v[8];
#pragma unroll
                    for (int n = 0; n < 2; ++n)
#pragma unroll
                        for (int e = 0; e < 4; ++e) v[4 * n + e] = acc[ai][bj][m][n][e] * rr;
                    if (kind == 0) { *(u32x4*)(S5IN + ((size_t)(c >> 4) * M_TOK + row) * 16 + (c & 15)) = pack8(v); }
                    else if (kind == 1) {
#pragma unroll
                        for (int e = 0; e < 8; ++e) v[e] *= 0.08838834764831845f;
                        *(u32x4*)(Q + (size_t)row * DM + c) = pack8(v); }
                    else if (kind == 2) { const f32x4 l0 = *(const f32x4*)(LB + c), l1 = *(const f32x4*)(LB + c + 4); _Float16 h[8];
#pragma unroll
                        for (int e = 0; e < 8; ++e) { const float lb = e < 4 ? l0[e] : l1[e - 4]; h[e] = (_Float16)__logf(lb + (1.f - lb) * sigm(v[e])); }
                        u32x4 w; w.x = (unsigned)__builtin_bit_cast(unsigned short, h[0]) | ((unsigned)__builtin_bit_cast(unsigned short, h[1]) << 16); w.y = (unsigned)__builtin_bit_cast(unsigned short, h[2]) | ((unsigned)__builtin_bit_cast(unsigned short, h[3]) << 16);
                        w.z = (unsigned)__builtin_bit_cast(unsigned short, h[4]) | ((unsigned)__builtin_bit_cast(unsigned short, h[5]) << 16); w.w = (unsigned)__builtin_bit_cast(unsigned short, h[6]) | ((unsigned)__builtin_bit_cast(unsigned short, h[7]) << 16);
                        *(u32x4*)(G16 + (size_t)row * DM + c) = w; }
                    else if (kind == 3) { *(u32x4*)(I + (size_t)row * DM + c) = pack8(v); }
                    else if (kind == 4) { float o[8]; unpack8(*(const u32x4*)(O + (size_t)row * DM + c), o); const float* rp = RINV + ((size_t)row * 8 + (c >> 7)) * 8; const f32x4 p0 = *(const f32x4*)rp, p1 = *(const f32x4*)(rp + 4); const float ri = __builtin_amdgcn_rsqf((((p0.x + p0.y) + (p0.z + p0.w)) + ((p1.x + p1.y) + (p1.z + p1.w))) * (1.0f / 128.0f) + 1e-6f); const f32x4 g0 = *(const f32x4*)(hg_gain + c), g1 = *(const f32x4*)(hg_gain + c + 4);
#pragma unroll
                        for (int e = 0; e < 8; ++e) o[e] = o[e] * ri * (e < 4 ? g0[e] : g1[e - 4]) * (v[e] * sigm(v[e]));
                        *(u32x4*)(O + (size_t)row * DM + c) = pack8(o); }
                    else {
#pragma unroll
                        for (int e = 0; e < 8; ++e) v[e] = sigm(v[e]);
                        *(u32x4*)((kind == 5 ? GA : GB) + (size_t)row * DM + c) = pack8(v); }
                } }
    }
};

struct EpiGlu {
    static constexpr bool PERM = true, AFTER_DRAIN = false;
    bf16_t* MIX;
    __device__ __forceinline__ void operator()(const f32x4 (&acc)[2][2][4][2], const Unit& u, int wr, int wc, int fr, int fq) const {
        const int row0 = u.pm * BM + wr * 64 + fr, ch0 = u.pn * HALF + wc * 32 + 8 * fq;
#pragma unroll
        for (int ai = 0; ai < 2; ++ai)
#pragma unroll
            for (int m = 0; m < 4; ++m) { bf16_t* p = MIX + (size_t)(row0 + ai * HALF + m * 16) * DM + ch0; float ga[8], h[8]; unpack8(*(const u32x4*)p, ga);
#pragma unroll
                for (int n = 0; n < 2; ++n)
#pragma unroll
                    for (int e = 0; e < 4; ++e) h[4 * n + e] = ga[4 * n + e] * acc[ai][0][m][n][e] * sigm(acc[ai][1][m][n][e]);
                *(u32x4*)p = pack8(h); }
    }
};
struct EpiHgOut {
    static constexpr bool PERM = true, AFTER_DRAIN = false;
    bf16_t* MIX; const bf16_t* GB;
    __device__ __forceinline__ void operator()(const f32x4 (&acc)[2][2][4][2], const Unit& u, int wr, int wc, int fr, int fq) const {
        const int row0 = u.pm * BM + wr * 64 + fr, c0 = u.pn * BM + wc * 32 + 8 * fq;
#pragma unroll
        for (int ai = 0; ai < 2; ++ai)
#pragma unroll
            for (int m = 0; m < 4; ++m)
#pragma unroll
                for (int bj = 0; bj < 2; ++bj) { const size_t off = (size_t)(row0 + ai * HALF + m * 16) * DM + c0 + bj * HALF; float a[8], b[8]; unpack8(*(const u32x4*)(MIX + off), a); unpack8(*(const u32x4*)(GB + off), b);
#pragma unroll
                    for (int n = 0; n < 2; ++n)
#pragma unroll
                        for (int e = 0; e < 4; ++e) a[4 * n + e] += b[4 * n + e] * acc[ai][bj][m][n][e];
                    *(u32x4*)(MIX + off) = pack8(a); }
    }
};
struct EpiPlain {
    static constexpr bool PERM = true, AFTER_DRAIN = false;
    bf16_t* O; int ldc;
    __device__ __forceinline__ void operator()(const f32x4 (&acc)[2][2][4][2], const Unit& u, int wr, int wc, int fr, int fq) const {
        const int row0 = u.pm * BM + wr * 64 + fr, c0 = u.pn * BM + wc * 32 + 8 * fq;
#pragma unroll
        for (int ai = 0; ai < 2; ++ai)
#pragma unroll
            for (int m = 0; m < 4; ++m)
#pragma unroll
                for (int bj = 0; bj < 2; ++bj) { float v[8];
#pragma unroll
                    for (int n = 0; n < 2; ++n)
#pragma unroll
                        for (int e = 0; e < 4; ++e) v[4 * n + e] = acc[ai][bj][m][n][e];
                    *(u32x4*)(O + (size_t)(row0 + ai * HALF + m * 16) * ldc + c0 + bj * HALF) = pack8(v); }
    }
};
struct EpiS5a {
    static constexpr bool PERM = true, AFTER_DRAIN = false;
    bf16_t* YS5; float* XL;
    __device__ __forceinline__ void operator()(const f32x4 (&acc)[2][2][4][2], const Unit& u, int wr, int wc, int fr, int fq) const {
        const int g = u.pm >> 1, pml = u.pm & 1, pnl = u.pn - 3 * g;
#pragma unroll
        for (int ai = 0; ai < 2; ++ai)
#pragma unroll
            for (int m = 0; m < 4; ++m) { const int R = pml * BM + ai * HALF + wr * 64 + m * 16 + fr;
#pragma unroll
                for (int bj = 0; bj < 2; ++bj) { float v[8];
#pragma unroll
                    for (int n = 0; n < 2; ++n)
#pragma unroll
                        for (int e = 0; e < 4; ++e) v[4 * n + e] = acc[ai][bj][m][n][e];
                    const int cl = bj * HALF + wc * 32 + 8 * fq;
                    if (pnl < 2) { const int ci = pnl * BM + cl, t = ci >> 4, ho = ci & 15; *(u32x4*)(YS5 + ((size_t)R * S5T + t) * 512 + g * 16 + ho) = pack8(v); }
                    else if (bj == 0) { float* p = XL + ((size_t)(g * S5ROWS + R)) * 128 + cl; *(f32x4*)p = (f32x4){v[0], v[1], v[2], v[3]}; *(f32x4*)(p + 4) = (f32x4){v[4], v[5], v[6], v[7]}; }
                } }
    }
};
struct EpiS5b {
    static constexpr bool PERM = true, AFTER_DRAIN = false;
    bf16_t* YS5;
    __device__ __forceinline__ void operator()(const f32x4 (&acc)[2][2][4][2], const Unit& u, int wr, int wc, int fr, int fq) const {
        const int g = u.pm >> 1, pml = u.pm & 1, pnl = u.pn & 1;
#pragma unroll
        for (int ai = 0; ai < 2; ++ai)
#pragma unroll
            for (int m = 0; m < 4; ++m) { const int R = pml * BM + ai * HALF + wr * 64 + m * 16 + fr;
#pragma unroll
                for (int bj = 0; bj < 2; ++bj) { const int ci = pnl * BM + bj * HALF + wc * 32 + 8 * fq, t = ci >> 4, ho = ci & 15; bf16_t* p = YS5 + ((size_t)R * S5T + t) * 512 + g * 16 + ho; float y[8]; unpack8(*(const u32x4*)p, y);
#pragma unroll
                    for (int n = 0; n < 2; ++n)
#pragma unroll
                        for (int e = 0; e < 4; ++e) { const float x = y[4 * n + e] + acc[ai][bj][m][n][e]; y[4 * n + e] = x * sigm(1.5957691216f * (x + 0.044715f * x * x * x)); }
                    *(u32x4*)p = pack8(y); } }
    }
};
}

constexpr int NWAVES = 8;
#ifndef MK_N_LAUNCHES
#define MK_N_LAUNCHES 1
#endif
constexpr int NPHASE = 19;
constexpr int N_LAUNCHES = MK_N_LAUNCHES;
using pg8::M_TOK; using pg8::DM; using pg8::FF; using pg8::NIN; using pg8::SEQ; using pg8::NBATCH; using pg8::S5T; using pg8::S5NC; using pg8::S5ROWS;
constexpr float NORM_EPS = 1e-6f;

constexpr size_t MiB = 1u << 20, KiB = 1u << 10;
constexpr size_t WS_CTL = 0, CTL_ZERO_BYTES = 1 * MiB;
constexpr size_t WS_W1GU = 1 * MiB, WS_W1D = 12 * MiB, WS_WIN = WS_W1D + 5632 * KiB, WS_WGLU = WS_WIN + 13 * MiB, WS_WHG = WS_WGLU + 2 * MiB, WS_WM = WS_WHG + 2 * MiB,
                 WS_W2GU = WS_WM + 2 * MiB, WS_W2D = WS_W2GU + 11 * MiB, WS_WPG = WS_W2D + 5632 * KiB, WS_WPP = WS_WPG + 2 * MiB;
static_assert(WS_WPP + 512 * KiB <= 56 * MiB, "weights");
constexpr size_t WS_TOEP = 56 * MiB;
constexpr size_t WS_CT = 80 * MiB;
constexpr size_t WS_RS = 88 * MiB, WS_RS2 = WS_RS + 256 * KiB, WS_RINV = WS_RS + 512 * KiB, WS_LB = 89 * MiB, WS_LAMT = WS_LB + 4 * KiB;
constexpr size_t WS_XB = 90 * MiB;
constexpr size_t WS_R = 122 * MiB;
constexpr size_t WS_HID = WS_R;
constexpr size_t WS_YS5 = WS_R, WS_S5IN = WS_R + 16 * MiB, WS_XL = WS_R + 32 * MiB, WS_XP = WS_R + 40 * MiB;
constexpr size_t WS_Q = WS_R + 16 * MiB, WS_G16 = WS_R + 48 * MiB, WS_I = WS_R + 80 * MiB;
constexpr size_t WS_PB = WS_R + 112 * MiB;
constexpr size_t WS_PP = WS_R;
constexpr size_t WS_DF = WS_PB + 8 * MiB;
constexpr size_t WS_RPART = WS_DF + 1 * MiB;
constexpr size_t WS_END = WS_RPART + 4 * MiB;
static_assert(WS_END <= 256 * MiB, "d_ws map");
constexpr int CW_BAR = 4096;

constexpr int RING_OFF = 0, RING_BYTES = 131072;
constexpr int LDSCTL_OFF = RING_BYTES, MISC_OFF = LDSCTL_OFF + 320;
constexpr int LDS_BYTES = 147456;

#define GAS __attribute__((address_space(1)))
#define LAS __attribute__((address_space(3)))
typedef unsigned short bf16;
typedef unsigned v4u __attribute__((ext_vector_type(4)));
typedef unsigned v2u __attribute__((ext_vector_type(2)));
typedef float f32x4 __attribute__((ext_vector_type(4)));
typedef float f32x2 __attribute__((ext_vector_type(2)));
typedef short bf16x8 __attribute__((ext_vector_type(8)));
typedef short s16x4 __attribute__((ext_vector_type(4)));
typedef GAS unsigned gu32;
#define RLX_AGENT __ATOMIC_RELAXED, __HIP_MEMORY_SCOPE_AGENT
#define LDS_WAIT() asm volatile("s_waitcnt lgkmcnt(0)" ::: "memory")
#define VM_WAIT() asm volatile("s_waitcnt vmcnt(0)" ::: "memory")
__device__ __forceinline__ unsigned f2bf(float f) { unsigned u = __builtin_bit_cast(unsigned, f); return (u + 0x7fffu + ((u >> 16) & 1u)) >> 16; }
__device__ __forceinline__ unsigned pk2(float lo, float hi) { return f2bf(lo) | (f2bf(hi) << 16); }
__device__ __forceinline__ float bflo(unsigned w) { return __builtin_bit_cast(float, w << 16); }
__device__ __forceinline__ float bfhi(unsigned w) { return __builtin_bit_cast(float, w & 0xffff0000u); }
#define XB_TMO      128
#define XB_XCNT(j)  (256  + 64 * (j))
#define XB_XSUB(j)  (1280 + 64 * (j))
#define XB_XGEN(j)  (2304 + 64 * (j))
#define XB_TOP      3328
#define XB_TOPGEN   3392
#define XCD_BAR_WORDS 3456
#define XB_SPIN_CAP (1u << 18)

__device__ __forceinline__ unsigned xb_ld(unsigned* p)              { return __hip_atomic_load(p, __ATOMIC_RELAXED, __HIP_MEMORY_SCOPE_AGENT); }
__device__ __forceinline__ unsigned xb_add(unsigned* p, unsigned v) { return __hip_atomic_fetch_add(p, v, __ATOMIC_RELAXED, __HIP_MEMORY_SCOPE_AGENT); }
__device__ __forceinline__ unsigned xb_xcc_id() { return (unsigned)__builtin_amdgcn_s_getreg((3 << 11) | 20) & 0xFu; }
#define XB_SPIN(cond, bar) do { unsigned _sp = 0; while (cond) { __builtin_amdgcn_s_sleep(1); \
    if ((++_sp & 255u) == 0u) { if (xb_ld(&(bar)[XB_TMO])) break; if (_sp > XB_SPIN_CAP) { atomicAdd(&(bar)[XB_TMO], 1u); break; } } } } while (0)

struct XcdBarrier {
    unsigned* bar; unsigned x; int wave;
    volatile LAS unsigned* st;
};

__device__ __forceinline__ XcdBarrier xcd_barrier_post(unsigned* bar, volatile LAS unsigned* st) {
    XcdBarrier b; b.bar = bar; b.x = xb_xcc_id(); b.st = st;
    if (threadIdx.x == 0) (void)xb_add(&bar[XB_XCNT(b.x)], 1u);
    return b;
}
__device__ __forceinline__ void xcd_barrier_complete(unsigned* bar, unsigned x, unsigned& nloc, unsigned& nx) {
    const unsigned G = gridDim.x * gridDim.y * gridDim.z;
    unsigned sum, cnt, mine, sp = 0u;
    for (;;) {
        sum = 0u; cnt = 0u; mine = 0u;
#pragma unroll
        for (unsigned j = 0; j < 16; ++j) { const unsigned c = xb_ld(&bar[XB_XCNT(j)]); sum += c; cnt += (c > 0u) ? 1u : 0u; mine = (j == x) ? c : mine; }
        if (sum == G) break;
        __builtin_amdgcn_s_sleep(1);
        if ((++sp & 255u) == 0u) { if (xb_ld(&bar[XB_TMO])) break; if (sp > XB_SPIN_CAP) { atomicAdd(&bar[XB_TMO], 1u); break; } }
    }
    nloc = mine > 0u ? mine : 1u; nx = cnt > 0u ? cnt : 1u;
}

__device__ __forceinline__ void xcd_barrier(const XcdBarrier& b) {
    asm volatile("s_waitcnt vmcnt(0)" ::: "memory");
    __syncthreads();
    if (b.wave == 0 && hw_lane() == 0) {
        unsigned* bar = b.bar;
        __builtin_amdgcn_s_waitcnt(0);
        unsigned nloc = b.st[0], nx = b.st[1];
        if (nloc == 0u) { xcd_barrier_complete(bar, b.x, nloc, nx); b.st[0] = nloc; b.st[1] = nx; }
        const unsigned old = xb_add(&bar[XB_XSUB(b.x)], 1u);
        const unsigned gen = old / nloc;
        if (old + 1u == (gen + 1u) * nloc) {
            __builtin_amdgcn_fence(__ATOMIC_RELEASE, "agent");
            asm volatile("s_waitcnt vmcnt(0)" ::: "memory");
            const unsigned og = xb_add(&bar[XB_TOP], 1u);
            const unsigned tg = og / nx;
            if (og + 1u == (tg + 1u) * nx) xb_add(&bar[XB_TOPGEN], 1u);
            else XB_SPIN(xb_ld(&bar[XB_TOPGEN]) == tg, bar);
            __builtin_amdgcn_fence(__ATOMIC_ACQUIRE, "agent");
            xb_add(&bar[XB_XGEN(b.x)], 1u);
            asm volatile("s_waitcnt vmcnt(0)" ::: "memory");
        } else {
            XB_SPIN(xb_ld(&bar[XB_XGEN(b.x)]) == gen, bar);
            __builtin_amdgcn_fence(__ATOMIC_ACQUIRE, "agent");
            asm volatile("s_waitcnt vmcnt(0)" ::: "memory");
        }
    }
    __syncthreads();
}

struct Frame {
    LAS unsigned char* lds;
    volatile LAS unsigned* MISC;
    gu32* ctl;
    int wave;
    int vcu, G;
    const float* in[30]; float* out; unsigned char* ws;
};
enum { IN_X = 0, IN_P, IN_FFN1_NORM, IN_FFN1_WG, IN_FFN1_WU, IN_FFN1_WD, IN_MIX_NORM, IN_WIN, IN_LAM_RE, IN_LAM_IM, IN_LOG_DT, IN_B_RE, IN_B_IM, IN_C_RE, IN_C_IM, IN_S5D, IN_GLU_VAL, IN_GLU_GATE,
       IN_HG_LB, IN_HG_NORM, IN_HG_WOUT, IN_WMERGE, IN_FFN2_NORM, IN_FFN2_WG, IN_FFN2_WU, IN_FFN2_WD, IN_PLE_NORM, IN_PLE_WG, IN_PLE_WP, IN_FINAL_NORM };

__device__ __forceinline__ float wave_sum(float v) {
#pragma unroll
    for (int o = 1; o < 64; o <<= 1) v += __shfl_xor(v, o);
    return v;
}
__device__ __forceinline__ void p0_transpose_item(const float* W, int K, int N, bf16* WT, const float* gain, float scale, int mode, LAS float* scr, int item, int lane) {
    const int nblk = N / 32, kb = item / nblk, nb = item % nblk, k0 = 64 * kb, n0 = 32 * nb;
#pragma unroll 8
    for (int i = 0; i < 32; ++i) { const int kk = 2 * i + (lane >> 5); const float gs = gain ? gain[k0 + kk] * scale : scale; scr[kk * 33 + (lane & 31)] = W[(size_t)(k0 + kk) * N + n0 + (lane & 31)] * gs; }
    LDS_WAIT(); asm volatile("" ::: "memory");
    const int c = lane & 7;
    const int nr0 = (mode == 0) ? n0 : 256 * (n0 >> 7) + (n0 & 127) + (mode == 2 ? 128 : 0);
#pragma unroll
    for (int j = 0; j < 4; ++j) { const int n = (lane >> 3) + 8 * j; const LAS float* s = scr + (8 * c) * 33 + n;
        v4u o; o.x = pk2(s[0 * 33], s[1 * 33]); o.y = pk2(s[2 * 33], s[3 * 33]); o.z = pk2(s[4 * 33], s[5 * 33]); o.w = pk2(s[6 * 33], s[7 * 33]);
        *(GAS v4u*)(WT + (size_t)(nr0 + n) * K + k0 + 8 * c) = o; }
    LDS_WAIT(); asm volatile("" ::: "memory");
}
struct cplx { double re, im; };
__device__ __forceinline__ cplx cmul(cplx a, cplx b) { return {a.re * b.re - a.im * b.im, a.re * b.im + a.im * b.re}; }
__device__ __forceinline__ cplx ldc(const LAS double* p, int i) { cplx r; r.re = p[2 * i]; r.im = p[2 * i + 1]; return r; }
__device__ __forceinline__ void stc(LAS double* p, int i, cplx v) { p[2 * i] = v.re; p[2 * i + 1] = v.im; }

__device__ __forceinline__ void p0_s5_tables(Frame& F, int g) {
    LAS double* LP = (LAS double*)(F.lds); LAS double* BB = (LAS double*)(F.lds + 33792); LAS float* KK = (LAS float*)(F.lds + 33792 + 16384);
    const float* lam_re = F.in[IN_LAM_RE] + g * 64; const float* lam_im = F.in[IN_LAM_IM] + g * 64;
    const float* b_re = F.in[IN_B_RE] + g * 1024; const float* b_im = F.in[IN_B_IM] + g * 1024;
    const float* c_re = F.in[IN_C_RE] + g * 1024; const float* c_im = F.in[IN_C_IM] + g * 1024;
    const int tid = F.wave * 64 + hw_lane();
    if (tid < 64) {
        const int p = tid; const double lr = (double)lam_re[p], li = (double)lam_im[p]; const double dt = exp((double)F.in[IN_LOG_DT][g]);
        const double er = exp(lr * dt); const double sn = sin(li * dt), cs = cos(li * dt);
        const cplx lb = {er * cs, er * sn}; cplx pw = {1.0, 0.0};
        for (int k = 0; k <= 32; ++k) { stc(LP, k * 64 + p, pw); if (k == 32) { ((float*)(F.ws + WS_LAMT))[(g * 64 + p) * 2] = (float)pw.re; ((float*)(F.ws + WS_LAMT))[(g * 64 + p) * 2 + 1] = (float)pw.im; } pw = cmul(pw, lb); }
        const double den = lr * lr + li * li; const cplx num = {lb.re - 1.0, lb.im}; const cplx coef = {(num.re * lr + num.im * li) / den, (num.im * lr - num.re * li) / den};
        for (int h = 0; h < 16; ++h) { const cplx b = {(double)b_re[p * 16 + h], (double)b_im[p * 16 + h]}; stc(BB, p * 16 + h, cmul(coef, b)); }
    }
    LDS_WAIT(); __syncthreads();
    for (int e = tid; e < 32 * 256; e += 512) { const int k = e >> 8, ho = (e >> 4) & 15, hi = e & 15; double s = 0.0;
        for (int p = 0; p < 64; ++p) { const cplx c = {(double)c_re[ho * 64 + p], (double)c_im[ho * 64 + p]}; const cplx t = cmul(ldc(LP, k * 64 + p), ldc(BB, p * 16 + hi)); s += c.re * t.re - c.im * t.im; }
        if (k == 0 && ho == hi) s += (double)F.in[IN_S5D][g * 16 + ho];
        KK[e] = (float)s; }
    LDS_WAIT(); __syncthreads();
    bf16* TO = (bf16*)(F.ws + WS_TOEP) + (size_t)g * 768 * 512;
    for (int ch = tid; ch < 768 * 64; ch += 512) { const int n = ch >> 6, cc = ch & 63, s = cc >> 1, hi0 = (cc & 1) * 8; float v[8];
        if (n < 512) { const int t = n >> 4, ho = n & 15;
#pragma unroll
            for (int e = 0; e < 8; ++e) v[e] = (s <= t) ? KK[((t - s) * 16 + ho) * 16 + hi0 + e] : 0.f; }
        else if (n < 640) { const int p = (n - 512) >> 1, ri = n & 1; const cplx l = ldc(LP, (31 - s) * 64 + p);
#pragma unroll
            for (int e = 0; e < 8; ++e) { const cplx w = cmul(l, ldc(BB, p * 16 + hi0 + e)); v[e] = (float)(ri ? w.im : w.re); } }
        else {
#pragma unroll
            for (int e = 0; e < 8; ++e) v[e] = 0.f; }
        v4u o; o.x = pk2(v[0], v[1]); o.y = pk2(v[2], v[3]); o.z = pk2(v[4], v[5]); o.w = pk2(v[6], v[7]);
        *(GAS v4u*)(TO + (size_t)n * 512 + cc * 8) = o; }
    bf16* CT = (bf16*)(F.ws + WS_CT) + (size_t)g * 512 * 256;
    for (int ch = tid; ch < 512 * 32; ch += 512) { const int n = ch >> 5, cc = ch & 31, t = n >> 4, ho = n & 15; float v[8];
        if (cc < 16) {
#pragma unroll
            for (int e = 0; e < 4; ++e) { const int p = cc * 4 + e; const cplx c = {(double)c_re[ho * 64 + p], (double)c_im[ho * 64 + p]}; const cplx z = cmul(c, ldc(LP, (t + 1) * 64 + p)); v[2 * e] = (float)z.re; v[2 * e + 1] = (float)(-z.im); } }
        else {
#pragma unroll
            for (int e = 0; e < 8; ++e) v[e] = 0.f; }
        v4u o; o.x = pk2(v[0], v[1]); o.y = pk2(v[2], v[3]); o.z = pk2(v[4], v[5]); o.w = pk2(v[6], v[7]);
        *(GAS v4u*)(CT + (size_t)n * 256 + cc * 8) = o; }
    LDS_WAIT(); __syncthreads();
}

__device__ __forceinline__ void p0_prologue(Frame& F) {
    if (F.vcu < 32) p0_s5_tables(F, F.vcu);
    const int lane = hw_lane(), tid = F.wave * 64 + lane;
    if (F.vcu == 32 && tid < 256) {
        const float* hb = F.in[IN_HG_LB]; float* LB = (float*)(F.ws + WS_LB);
        for (int c = tid; c < 1024; c += 256) { const float a0 = hb[c], a1 = hb[1024 + c]; LB[c] = 1.f / (1.f + expf(a1 - a0)); }
    }
    LAS float* scr = (LAS float*)(F.lds + RING_OFF + F.wave * 16384);
    const int gw = F.vcu * NWAVES + F.wave, NGW = F.G * NWAVES;
    int base = 0;
#define P0_W(INW, KK_, NN_, OFF, GAINP, SCALE, MODE) { constexpr int ni = ((KK_) / 64) * ((NN_) / 32); int first = (gw - base) % NGW; if (first < 0) first += NGW; \
        for (int it = first; it < ni; it += NGW) p0_transpose_item(F.in[INW], KK_, NN_, (bf16*)(F.ws + (OFF)), GAINP, SCALE, MODE, scr, it, lane); base += ni; }
    P0_W(IN_FFN1_WG, 1024, 2816, WS_W1GU, F.in[IN_FFN1_NORM], 1.f, 1) P0_W(IN_FFN1_WU, 1024, 2816, WS_W1GU, F.in[IN_FFN1_NORM], 1.f, 2) P0_W(IN_FFN1_WD, 2816, 1024, WS_W1D, nullptr, 0.5f, 0)
    P0_W(IN_WIN, 1024, 6656, WS_WIN, F.in[IN_MIX_NORM], 1.f, 0) P0_W(IN_GLU_VAL, 512, 1024, WS_WGLU, nullptr, 1.f, 1) P0_W(IN_GLU_GATE, 512, 1024, WS_WGLU, nullptr, 1.f, 2)
    P0_W(IN_HG_WOUT, 1024, 1024, WS_WHG, nullptr, 1.f, 0) P0_W(IN_WMERGE, 1024, 1024, WS_WM, nullptr, 1.f, 0)
    P0_W(IN_FFN2_WG, 1024, 2816, WS_W2GU, F.in[IN_FFN2_NORM], 1.f, 1) P0_W(IN_FFN2_WU, 1024, 2816, WS_W2GU, F.in[IN_FFN2_NORM], 1.f, 2) P0_W(IN_FFN2_WD, 2816, 1024, WS_W2D, nullptr, 0.5f, 0)
    P0_W(IN_PLE_WG, 1024, 1024, WS_WPG, F.in[IN_PLE_NORM], 1.f, 0) P0_W(IN_PLE_WP, 256, 1024, WS_WPP, nullptr, 1.f, 0)
#undef P0_W
    const float* x = F.in[IN_X]; bf16* XB = (bf16*)(F.ws + WS_XB); float* RS = (float*)(F.ws + WS_RS);
    for (int m = gw; m < M_TOK; m += NGW) { const GAS f32x4* xr = (const GAS f32x4*)(x + (size_t)m * DM) + lane; f32x4 v[4]; float s = 0.f;
#pragma unroll
        for (int j = 0; j < 4; ++j) { v[j] = xr[64 * j]; s += (v[j].x * v[j].x + v[j].y * v[j].y) + (v[j].z * v[j].z + v[j].w * v[j].w); }
        s = wave_sum(s);
        GAS v2u* o8 = (GAS v2u*)(XB + (size_t)m * DM) + lane;
#pragma unroll
        for (int j = 0; j < 4; ++j) { v2u w; w.x = pk2(v[j].x, v[j].y); w.y = pk2(v[j].z, v[j].w); o8[64 * j] = w; }
        if (lane == 0) *(f32x4*)(RS + (size_t)m * 4) = (f32x4){s, 0.f, 0.f, 0.f}; }
    const float* pin = F.in[IN_P]; bf16* PB = (bf16*)(F.ws + WS_PB);
    for (size_t i = (size_t)gw * 64 + lane; i < (size_t)M_TOK * 256 / 4; i += (size_t)NGW * 64) { const f32x4 v = ((const GAS f32x4*)pin)[i]; v2u w; w.x = pk2(v.x, v.y); w.y = pk2(v.z, v.w); ((GAS v2u*)PB)[i] = w; }
}

__device__ __forceinline__ void s5_scan_phase(Frame& F) {
    const int idx = blockIdx.x * 512 + F.wave * 64 + hw_lane(); if (idx >= 32 * NBATCH * 64) return;
    const int g = idx >> 8, b = (idx >> 6) & 3, p = idx & 63;
    const float* XL = (const float*)(F.ws + WS_XL) + ((size_t)(g * S5ROWS + b * S5NC)) * 128 + 2 * p; unsigned* XP = (unsigned*)(F.ws + WS_XP) + ((size_t)(g * S5ROWS + b * S5NC)) * 128 + p;
    const f32x2 lt = *(const f32x2*)((const float*)(F.ws + WS_LAMT) + (g * 64 + p) * 2);
    float xr = 0.f, xi = 0.f;
#pragma unroll 8
    for (int c = 0; c < S5NC; ++c) { const f32x2 l = *(const f32x2*)(XL + (size_t)c * 128);
        XP[(size_t)c * 128] = pk2(xr, xi); XP[(size_t)c * 128 + 64] = 0u;
        const float nr = lt.x * xr - lt.y * xi + l.x, ni = lt.x * xi + lt.y * xr + l.y; xr = nr; xi = ni; }
}

__device__ __forceinline__ void final_norm_phase(Frame& F) {
    const int gw = F.vcu * NWAVES + F.wave, NGW = F.G * NWAVES; const float* RS2 = (const float*)(F.ws + WS_RS2); const float* fn = F.in[IN_FINAL_NORM]; const int lane = hw_lane();
    f32x4 gn[4];
#pragma unroll
    for (int j = 0; j < 4; ++j) gn[j] = ((const f32x4*)fn)[lane + 64 * j];
    for (int m = gw; m < M_TOK; m += NGW) { const f32x4 p = *(const f32x4*)(RS2 + (size_t)m * 4); const float r = 1.0f / sqrtf(((p.x + p.y) + (p.z + p.w)) * (1.0f / 1024.0f) + NORM_EPS);
        GAS f32x4* o = (GAS f32x4*)(F.out + (size_t)m * DM) + lane;
#pragma unroll
        for (int j = 0; j < 4; ++j) { f32x4 v = o[64 * j]; v = v * r * gn[j]; o[64 * j] = v; } }
}

constexpr int PA_GC = 0, PA_QT = 32768, PA_KT = PA_QT + 17408, PA_VV = PA_KT + 17408, PA_P = PA_VV + 17408, PA_TOT = PA_P + 9216, PA_GL = PA_TOT + 2048;
static_assert(PA_GL + 512 <= RING_BYTES, "hgrn pass A lds");
__device__ __forceinline__ float h2f(unsigned short h) { return (float)__builtin_bit_cast(_Float16, h); }
__device__ __forceinline__ void tr_frag2(unsigned addr, bf16x8& f0, bf16x8& f1) {
    s16x4 a, b, c, d;
    asm volatile("ds_read_b64_tr_b16 %0, %4\n\tds_read_b64_tr_b16 %1, %4 offset:1088\n\tds_read_b64_tr_b16 %2, %4 offset:8704\n\tds_read_b64_tr_b16 %3, %4 offset:9792\n\ts_waitcnt lgkmcnt(0)"
                 : "=&v"(a), "=&v"(b), "=&v"(c), "=&v"(d) : "v"(addr) : "memory");
    f0 = (bf16x8){a[0], a[1], a[2], a[3], b[0], b[1], b[2], b[3]}; f1 = (bf16x8){c[0], c[1], c[2], c[3], d[0], d[1], d[2], d[3]};
}
__device__ __forceinline__ void hgrn_pass_a(Frame& F) {
    const int lane = hw_lane(), w = F.wave, tid = w * 64 + lane, l15 = lane & 15, lg = lane >> 4;
    LAS unsigned char* L = F.lds;
    LAS float* GC = (LAS float*)(L + PA_GC); LAS float* TOT = (LAS float*)(L + PA_TOT); LAS float* GL = (LAS float*)(L + PA_GL);
    bf16* Qg = (bf16*)(F.ws + WS_Q); unsigned short* Gg = (unsigned short*)(F.ws + WS_G16); bf16* Ig = (bf16*)(F.ws + WS_I); bf16* OI = (bf16*)(F.ws + WS_TOEP); float* DF = (float*)(F.ws + WS_DF);
    const int s_ = tid >> 3, kb = tid & 7, ck = tid & 127, cgp = tid >> 7;
    const size_t laneoff = (size_t)lg * 1024 + l15 * 8;
    const unsigned trbase = (unsigned)(8 * lg + (l15 >> 2)) * 272u + (unsigned)(l15 & 3) * 8u;
    int u = F.vcu;
    v4u q0, q1, g0, g1, i0, i1;
    if (u < 2048) { const int bh = u >> 6, c = u & 63; const size_t off = ((size_t)(bh >> 3) * SEQ + c * 64 + s_) * DM + (bh & 7) * 128 + kb * 16;
        q0 = *(const GAS v4u*)(Qg + off); q1 = *(const GAS v4u*)(Qg + off + 8); g0 = *(const GAS v4u*)(Gg + off); g1 = *(const GAS v4u*)(Gg + off + 8); i0 = *(const GAS v4u*)(Ig + off); i1 = *(const GAS v4u*)(Ig + off + 8); }
#pragma unroll 1
    for (; u < 2048; u += F.G) {
        const int bh = u >> 6, c = u & 63; const size_t E0 = ((size_t)(bh >> 3) * SEQ + c * 64) * DM + (bh & 7) * 128;
        float qv[16], gv[16];
        { const unsigned qa[8] = {q0.x, q0.y, q0.z, q0.w, q1.x, q1.y, q1.z, q1.w}, ga[8] = {g0.x, g0.y, g0.z, g0.w, g1.x, g1.y, g1.z, g1.w};
#pragma unroll
          for (int j = 0; j < 8; ++j) { qv[2 * j] = bflo(qa[j]); qv[2 * j + 1] = bfhi(qa[j]); gv[2 * j] = h2f((unsigned short)(ga[j] & 0xffffu)); gv[2 * j + 1] = h2f((unsigned short)(ga[j] >> 16)); } }
#pragma unroll
        for (int j = 0; j < 4; ++j) *(LAS f32x4*)(GC + s_ * 128 + kb * 16 + 4 * j) = (f32x4){gv[4 * j], gv[4 * j + 1], gv[4 * j + 2], gv[4 * j + 3]};
        *(LAS v4u*)(L + PA_VV + s_ * 272 + kb * 32) = i0; *(LAS v4u*)(L + PA_VV + s_ * 272 + kb * 32 + 16) = i1;
        { const int un = u + F.G; if (un < 2048) { const int bh2 = un >> 6, c2 = un & 63; const size_t off = ((size_t)(bh2 >> 3) * SEQ + c2 * 64 + s_) * DM + (bh2 & 7) * 128 + kb * 16;
            q0 = *(const GAS v4u*)(Qg + off); q1 = *(const GAS v4u*)(Qg + off + 8); g0 = *(const GAS v4u*)(Gg + off); g1 = *(const GAS v4u*)(Gg + off + 8); i0 = *(const GAS v4u*)(Ig + off); i1 = *(const GAS v4u*)(Ig + off + 8); } }
        LDS_WAIT(); __builtin_amdgcn_s_barrier(); asm volatile("" ::: "memory");
        { float loc[16]; float run = 0.f;
#pragma unroll
          for (int j = 0; j < 16; ++j) { run += GC[(cgp * 16 + j) * 128 + ck]; loc[j] = run; }
          TOT[cgp * 128 + ck] = run;
          LDS_WAIT(); __builtin_amdgcn_s_barrier(); asm volatile("" ::: "memory");
          float off = 0.f;
#pragma unroll
          for (int gg = 0; gg < 3; ++gg) off += (gg < cgp) ? TOT[gg * 128 + ck] : 0.f;
#pragma unroll
          for (int j = 0; j < 16; ++j) GC[(cgp * 16 + j) * 128 + ck] = loc[j] + off;
          if (cgp == 3) { const float gl = loc[15] + off; GL[ck] = gl; DF[(size_t)u * 128 + ck] = __expf(gl); } }
        LDS_WAIT(); __builtin_amdgcn_s_barrier(); asm volatile("" ::: "memory");
        { float qt[16], kt[16];
#pragma unroll
          for (int j = 0; j < 16; ++j) { const float d = GC[s_ * 128 + kb * 16 + j] - GL[kb * 16 + j]; const float E = __expf(d), Ei = __expf(-d); const float kk = 1.f - __expf(gv[j]); qt[j] = qv[j] * E; kt[j] = kk * Ei; }
          v4u a, bq;
          a.x = pk2(qt[0], qt[1]); a.y = pk2(qt[2], qt[3]); a.z = pk2(qt[4], qt[5]); a.w = pk2(qt[6], qt[7]); bq.x = pk2(qt[8], qt[9]); bq.y = pk2(qt[10], qt[11]); bq.z = pk2(qt[12], qt[13]); bq.w = pk2(qt[14], qt[15]);
          *(LAS v4u*)(L + PA_QT + s_ * 272 + kb * 32) = a; *(LAS v4u*)(L + PA_QT + s_ * 272 + kb * 32 + 16) = bq;
          a.x = pk2(kt[0], kt[1]); a.y = pk2(kt[2], kt[3]); a.z = pk2(kt[4], kt[5]); a.w = pk2(kt[6], kt[7]); bq.x = pk2(kt[8], kt[9]); bq.y = pk2(kt[10], kt[11]); bq.z = pk2(kt[12], kt[13]); bq.w = pk2(kt[14], kt[15]);
          *(LAS v4u*)(L + PA_KT + s_ * 272 + kb * 32) = a; *(LAS v4u*)(L + PA_KT + s_ * 272 + kb * 32 + 16) = bq; }
        LDS_WAIT(); __builtin_amdgcn_s_barrier(); asm volatile("" ::: "memory");
        { const int tm = w >> 1;
#pragma unroll
          for (int jn = 0; jn < 2; ++jn) { const int tn = 2 * (w & 1) + jn; f32x4 sc = (f32x4){0.f, 0.f, 0.f, 0.f};
            if (tn <= tm) {
#pragma unroll
                for (int ks = 0; ks < 4; ++ks) { const bf16x8 a = *(const LAS bf16x8*)(L + PA_KT + (16 * tn + l15) * 272 + (32 * ks + 8 * lg) * 2); const bf16x8 bb = *(const LAS bf16x8*)(L + PA_QT + (16 * tm + l15) * 272 + (32 * ks + 8 * lg) * 2);
                    sc = __builtin_amdgcn_mfma_f32_16x16x32_bf16(a, bb, sc, 0, 0, 0); } }
            const int t = 16 * tm + l15, s0 = 16 * tn + 4 * lg; v2u pw; pw.x = pk2(s0 <= t ? sc[0] : 0.f, s0 + 1 <= t ? sc[1] : 0.f); pw.y = pk2(s0 + 2 <= t ? sc[2] : 0.f, s0 + 3 <= t ? sc[3] : 0.f);
            *(LAS v2u*)(L + PA_P + t * 144 + s0 * 2) = pw; } }
        bf16x8 vf0, vf1, kf0, kf1;
        tr_frag2((unsigned)(size_t)(L + PA_VV) + trbase + (unsigned)w * 32u, vf0, vf1);
        tr_frag2((unsigned)(size_t)(L + PA_KT) + trbase + (unsigned)w * 32u, kf0, kf1);
        *(GAS bf16x8*)(Ig + E0 + (size_t)(2 * w) * 4096 + laneoff) = vf0; *(GAS bf16x8*)(Ig + E0 + (size_t)(2 * w + 1) * 4096 + laneoff) = vf1;
        *(GAS bf16x8*)(Gg + E0 + (size_t)(2 * w) * 4096 + laneoff) = kf0; *(GAS bf16x8*)(Gg + E0 + (size_t)(2 * w + 1) * 4096 + laneoff) = kf1;
#pragma unroll
        for (int j = 0; j < 2; ++j) { const int f = 2 * w + j, tmq = f >> 2, iq = f & 3; const v2u lo = *(const LAS v2u*)(L + PA_QT + (16 * tmq + l15) * 272 + (32 * iq + 4 * lg) * 2), hi = *(const LAS v2u*)(L + PA_QT + (16 * tmq + l15) * 272 + (32 * iq + 16 + 4 * lg) * 2);
            v4u o; o.x = lo.x; o.y = lo.y; o.z = hi.x; o.w = hi.y; *(GAS v4u*)(Qg + E0 + (size_t)f * 4096 + laneoff) = o; }
        LDS_WAIT(); __builtin_amdgcn_s_barrier(); asm volatile("" ::: "memory");
#pragma unroll
        for (int tm = 0; tm < 4; ++tm) { f32x4 a4 = (f32x4){0.f, 0.f, 0.f, 0.f};
            { const bf16x8 pf = *(const LAS bf16x8*)(L + PA_P + (16 * tm + l15) * 144 + (8 * lg) * 2); a4 = __builtin_amdgcn_mfma_f32_16x16x32_bf16(vf0, pf, a4, 0, 0, 0); }
            if (tm >= 2) { const bf16x8 pf = *(const LAS bf16x8*)(L + PA_P + (16 * tm + l15) * 144 + (32 + 8 * lg) * 2); a4 = __builtin_amdgcn_mfma_f32_16x16x32_bf16(vf1, pf, a4, 0, 0, 0); }
            v2u ow; ow.x = pk2(a4[0], a4[1]); ow.y = pk2(a4[2], a4[3]); *(GAS v2u*)(OI + E0 + (size_t)(16 * tm + l15) * DM + 16 * w + 4 * lg) = ow; }
    }
}

constexpr int PB_QF = 0, PB_KTF = 16384, PB_VTF = 32768, PB_DF = 49152, PB_SLOT = 49152 + 512;
static_assert(2 * PB_SLOT <= RING_BYTES, "hgrn pass B lds");
__device__ __forceinline__ void hgrn_pass_b(Frame& F) {
    if (F.vcu >= 32) return;
    const int lane = hw_lane(), l15 = lane & 15, lg = lane >> 4, bh = F.vcu, w = F.wave, b = bh >> 3, h = bh & 7;
    LAS unsigned char* L = F.lds;
    const bf16* Qg = (const bf16*)(F.ws + WS_Q); const bf16* Kg = (const bf16*)(F.ws + WS_G16); const bf16* Vg = (const bf16*)(F.ws + WS_I); bf16* OI = (bf16*)(F.ws + WS_TOEP);
    const float* DF = (const float*)(F.ws + WS_DF); float* RPART = (float*)(F.ws + WS_RPART);
    const size_t laneoff = (size_t)lg * 1024 + l15 * 8;
    const size_t Eb = ((size_t)b * SEQ) * DM + h * 128;
    f32x4 S[8];
#pragma unroll
    for (int i = 0; i < 8; ++i) S[i] = (f32x4){0.f, 0.f, 0.f, 0.f};
#define PB_ISSUE(cc, SLOT) do { const size_t E0_ = Eb + (size_t)(cc) * 64 * DM; LAS unsigned char* sl_ = L + (SLOT) * PB_SLOT; \
        _Pragma("unroll") for (int f_ = 0; f_ < 2; ++f_) { \
            __builtin_amdgcn_global_load_lds((const unsigned*)(Qg + E0_ + (size_t)(2 * w + f_) * 4096 + laneoff), (LAS unsigned*)(sl_ + PB_QF + (2 * w + f_) * 1024), 16, 0, 0); \
            __builtin_amdgcn_global_load_lds((const unsigned*)(Kg + E0_ + (size_t)(2 * w + f_) * 4096 + laneoff), (LAS unsigned*)(sl_ + PB_KTF + (2 * w + f_) * 1024), 16, 0, 0); \
            __builtin_amdgcn_global_load_lds((const unsigned*)(Vg + E0_ + (size_t)(2 * w + f_) * 4096 + laneoff), (LAS unsigned*)(sl_ + PB_VTF + (2 * w + f_) * 1024), 16, 0, 0); } \
        if (w < 2) __builtin_amdgcn_global_load_lds((const unsigned*)(DF + ((size_t)bh * 64 + (cc)) * 128 + w * 64 + lane), (LAS unsigned*)(sl_ + PB_DF + w * 256), 4, 0, 0); } while (0)
    PB_ISSUE(0, 0);
    v2u oi[4];
#pragma unroll
    for (int tm = 0; tm < 4; ++tm) oi[tm] = *(const GAS v2u*)(OI + Eb + (size_t)(16 * tm + l15) * DM + 16 * w + 4 * lg);
#define PB_CHUNK(c, SLOT) do { \
        asm volatile("s_waitcnt vmcnt(0) lgkmcnt(0)" ::: "memory");            \
        f32x4 acc[4]; \
        _Pragma("unroll") for (int tm = 0; tm < 4; ++tm) acc[tm] = (f32x4){bflo(oi[tm].x), bfhi(oi[tm].x), bflo(oi[tm].y), bfhi(oi[tm].y)}; \
        _Pragma("unroll") for (int tm = 0; tm < 4; ++tm) asm volatile("" : "+v"(acc[tm])); \
        __builtin_amdgcn_s_barrier(); asm volatile("" ::: "memory");            \
        __builtin_amdgcn_sched_barrier(0); \
        if ((c) + 1 < SEQ / 64) PB_ISSUE((c) + 1, 1 - (SLOT)); \
        LAS unsigned char* sl = L + (SLOT) * PB_SLOT; \
        if ((c) + 1 < SEQ / 64) { \
            _Pragma("unroll") for (int tm = 0; tm < 4; ++tm) oi[tm] = *(const GAS v2u*)(OI + Eb + (size_t)(((c) + 1) * 64 + 16 * tm + l15) * DM + 16 * w + 4 * lg); } \
        bf16x8 Sf[4]; \
        _Pragma("unroll") for (int kt = 0; kt < 8; ++kt) { const f32x4 d = *(const LAS f32x4*)(sl + PB_DF + (16 * kt + 4 * lg) * 4); S[kt] = S[kt] * d; } \
        _Pragma("unroll") for (int i = 0; i < 4; ++i) { v4u u_; u_.x = pk2(S[2 * i][0], S[2 * i][1]); u_.y = pk2(S[2 * i][2], S[2 * i][3]); u_.z = pk2(S[2 * i + 1][0], S[2 * i + 1][1]); u_.w = pk2(S[2 * i + 1][2], S[2 * i + 1][3]); Sf[i] = __builtin_bit_cast(bf16x8, u_); } \
        _Pragma("unroll") for (int tm = 0; tm < 4; ++tm) \
            _Pragma("unroll") for (int i = 0; i < 4; ++i) { const bf16x8 qf = *(const LAS bf16x8*)(sl + PB_QF + (tm * 4 + i) * 1024 + lane * 16); acc[tm] = __builtin_amdgcn_mfma_f32_16x16x32_bf16(Sf[i], qf, acc[tm], 0, 0, 0); } \
        { const bf16x8 v0 = *(const LAS bf16x8*)(sl + PB_VTF + (2 * w) * 1024 + lane * 16), v1 = *(const LAS bf16x8*)(sl + PB_VTF + (2 * w + 1) * 1024 + lane * 16); \
          _Pragma("unroll") for (int kt = 0; kt < 8; ++kt) { const bf16x8 k0 = *(const LAS bf16x8*)(sl + PB_KTF + (2 * kt) * 1024 + lane * 16), k1 = *(const LAS bf16x8*)(sl + PB_KTF + (2 * kt + 1) * 1024 + lane * 16); \
              S[kt] = __builtin_amdgcn_mfma_f32_16x16x32_bf16(k0, v0, S[kt], 0, 0, 0); S[kt] = __builtin_amdgcn_mfma_f32_16x16x32_bf16(k1, v1, S[kt], 0, 0, 0); } } \
        _Pragma("unroll") for (int tm = 0; tm < 4; ++tm) { const f32x4 o = acc[tm]; const size_t row = (size_t)b * SEQ + (c) * 64 + 16 * tm + l15; v2u ow; ow.x = pk2(o[0], o[1]); ow.y = pk2(o[2], o[3]); \
            *(GAS v2u*)(OI + row * DM + h * 128 + 16 * w + 4 * lg) = ow; \
            float s = (o[0] * o[0] + o[1] * o[1]) + (o[2] * o[2] + o[3] * o[3]); s += __shfl_xor(s, 16); s += __shfl_xor(s, 32); \
            if (lg == 0) RPART[(row * 8 + h) * 8 + w] = s; } } while (0)
#pragma unroll 1
    for (int c2 = 0; c2 < SEQ / 64; c2 += 2) { PB_CHUNK(c2, 0); PB_CHUNK(c2 + 1, 1); }
#undef PB_CHUNK
#undef PB_ISSUE
}

struct Args { const float* in[30]; float* out; unsigned char* ws; int ph_lo, ph_hi; };
__global__ void __launch_bounds__(NWAVES * 64, 2) blk_fwd(Args args) {
    extern __shared__ __attribute__((aligned(16))) unsigned char lds[];
    Frame F;
    F.lds = (LAS unsigned char*)lds;
    F.MISC = (volatile LAS unsigned*)(F.lds + MISC_OFF);
    F.wave = __builtin_amdgcn_readfirstlane((int)threadIdx.x >> 6);
    F.G = gridDim.x; { const int bx = blockIdx.x; F.vcu = (F.G % 8 == 0) ? (bx % 8) * (F.G / 8) + bx / 8 : bx; }
    F.ws = args.ws; F.out = args.out; F.ctl = (gu32*)(args.ws + WS_CTL);
#pragma unroll
    for (int i = 0; i < 30; ++i) F.in[i] = args.in[i];
    for (int u = (int)threadIdx.x; u < (LDS_BYTES - LDSCTL_OFF) / 4; u += NWAVES * 64) ((LAS unsigned*)(F.lds + LDSCTL_OFF))[u] = 0u;
    __syncthreads();
    XcdBarrier bar; bar.bar = (unsigned*)(F.ctl + CW_BAR); bar.x = 0; bar.st = nullptr; bar.wave = F.wave;
    if (N_LAUNCHES == 1) { bar = xcd_barrier_post((unsigned*)(F.ctl + CW_BAR), F.MISC + 8); bar.wave = F.wave; }
    const int lo = args.ph_lo, hi = args.ph_hi;
#ifndef PROBE_REP
#define PROBE_REP -1
#endif
#ifndef PHASE_MASK
#define PHASE_MASK 0x7ffff
#endif
#define IN(k) ((((PHASE_MASK) >> (k)) & 1) && lo <= (k) && (k) < hi)
#define SEAM(k) do { if (IN(k) && IN((k) + 1)) xcd_barrier(bar); } while (0)
    using namespace pg8;
    bf16_t* const XB = (bf16_t*)(F.ws + WS_XB); float* const RS = (float*)(F.ws + WS_RS); float* const RS2 = (float*)(F.ws + WS_RS2);
    bf16_t* const HID = (bf16_t*)(F.ws + WS_HID); bf16_t* const WIN = (bf16_t*)(F.ws + WS_WIN);
    const int cid = (int)blockIdx.x;

    if (IN(0)) { if (PROBE_REP == 0) { p0_prologue(F); xcd_barrier(bar); } p0_prologue(F); } SEAM(0);
    if (IN(1)) { Gemm g{XB, (const bf16_t*)(F.ws + WS_W1GU), M_TOK, 2 * FF, DM}; StaticOrder S; S.init(M_TOK, 2 * FF, F.G, cid); EpiSwiglu E{HID, RS};
        gemm_phase<EpiSwiglu, StaticOrder, true, true>(F.lds + RING_OFF, g, S, E, F.wave); } SEAM(1);
    if (IN(2)) { Gemm g{HID, (const bf16_t*)(F.ws + WS_W1D), M_TOK, DM, FF}; StaticOrder S; S.init(M_TOK, DM, F.G, cid); EpiResid E{F.in[IN_X], F.out, XB, RS};
        gemm_phase<EpiResid, StaticOrder, false, true>(F.lds + RING_OFF, g, S, E, F.wave); } SEAM(2);
#define MK_EP(off) EpiProj EP{off, RS, (bf16_t*)(F.ws + WS_S5IN), (bf16_t*)(F.ws + WS_Q), (unsigned short*)(F.ws + WS_G16), (bf16_t*)(F.ws + WS_I), (bf16_t*)(F.ws + WS_TOEP), (const float*)(F.ws + WS_RPART), F.in[IN_HG_NORM], \
               (bf16_t*)(F.ws + WS_G16), (bf16_t*)(F.ws + WS_I), (const float*)(F.ws + WS_LB)}
    if (IN(3)) { Gemm g{XB, WIN, M_TOK, 512, DM}; StaticOrder S; S.init(M_TOK, 512, F.G, cid); MK_EP(0);
        gemm_phase<EpiProj, StaticOrder, true, true>(F.lds + RING_OFF, g, S, EP, F.wave); } SEAM(3);
    if (IN(4)) { Gemm g{(const bf16_t*)(F.ws + WS_S5IN), (const bf16_t*)(F.ws + WS_TOEP), 32 * S5ROWS, 32 * 768, 512}; BatchOrder S; S.init(32, 2, 3, F.G, cid); EpiS5a E{(bf16_t*)(F.ws + WS_YS5), (float*)(F.ws + WS_XL)};
        gemm_phase<EpiS5a, BatchOrder, true, true>(F.lds + RING_OFF, g, S, E, F.wave); } SEAM(4);
    if (IN(5)) { if (PROBE_REP == 5) { s5_scan_phase(F); xcd_barrier(bar); } s5_scan_phase(F); } SEAM(5);
    if (IN(6)) { Gemm g{(const bf16_t*)(F.ws + WS_XP), (const bf16_t*)(F.ws + WS_CT), 32 * S5ROWS, 32 * 512, 256}; BatchOrder S; S.init(32, 2, 2, F.G, cid); EpiS5b E{(bf16_t*)(F.ws + WS_YS5)};
        gemm_phase<EpiS5b, BatchOrder, true, true>(F.lds + RING_OFF, g, S, E, F.wave); } SEAM(6);
    if (IN(7)) { Gemm g{XB, WIN + (size_t)512 * DM, M_TOK, 3072, DM}; StaticOrder S; S.init(M_TOK, 3072, F.G, cid); MK_EP(2);
        gemm_phase<EpiProj, StaticOrder, true, true>(F.lds + RING_OFF, g, S, EP, F.wave); } SEAM(7);
    if (IN(8)) { hgrn_pass_a(F); } SEAM(8);
    if (IN(9)) { hgrn_pass_b(F); } SEAM(9);
    if (IN(10)) { Gemm g{XB, WIN + (size_t)3584 * DM, M_TOK, 3072, DM}; StaticOrder S; S.init(M_TOK, 3072, F.G, cid); MK_EP(14);
        gemm_phase<EpiProj, StaticOrder, true, true>(F.lds + RING_OFF, g, S, EP, F.wave); } SEAM(10);
    if (IN(11)) { Gemm g{(const bf16_t*)(F.ws + WS_YS5), (const bf16_t*)(F.ws + WS_WGLU), M_TOK, 2048, 512}; StaticOrder S; S.init(M_TOK, 2048, F.G, cid); EpiGlu E{(bf16_t*)(F.ws + WS_G16)};
        gemm_phase<EpiGlu, StaticOrder, true, true>(F.lds + RING_OFF, g, S, E, F.wave); } SEAM(11);
    if (IN(12)) { Gemm g{(const bf16_t*)(F.ws + WS_TOEP), (const bf16_t*)(F.ws + WS_WHG), M_TOK, DM, DM}; StaticOrder S; S.init(M_TOK, DM, F.G, cid); EpiHgOut E{(bf16_t*)(F.ws + WS_G16), (const bf16_t*)(F.ws + WS_I)};
        gemm_phase<EpiHgOut, StaticOrder, true, true>(F.lds + RING_OFF, g, S, E, F.wave); } SEAM(12);
    if (IN(13)) { Gemm g{(const bf16_t*)(F.ws + WS_G16), (const bf16_t*)(F.ws + WS_WM), M_TOK, DM, DM}; StaticOrder S; S.init(M_TOK, DM, F.G, cid); EpiResid E{F.out, F.out, XB, RS};
        gemm_phase<EpiResid, StaticOrder, false, true>(F.lds + RING_OFF, g, S, E, F.wave); } SEAM(13);
    if (IN(14)) { Gemm g{XB, (const bf16_t*)(F.ws + WS_W2GU), M_TOK, 2 * FF, DM}; StaticOrder S; S.init(M_TOK, 2 * FF, F.G, cid); EpiSwiglu E{HID, RS};
        gemm_phase<EpiSwiglu, StaticOrder, true, true>(F.lds + RING_OFF, g, S, E, F.wave); } SEAM(14);
    if (IN(15)) { Gemm g{HID, (const bf16_t*)(F.ws + WS_W2D), M_TOK, DM, FF}; StaticOrder S; S.init(M_TOK, DM, F.G, cid); EpiResid E{F.out, F.out, XB, RS};
        gemm_phase<EpiResid, StaticOrder, false, true>(F.lds + RING_OFF, g, S, E, F.wave); } SEAM(15);
    if (IN(16)) { Gemm g{(const bf16_t*)(F.ws + WS_PB), (const bf16_t*)(F.ws + WS_WPP), M_TOK, DM, 256}; StaticOrder S; S.init(M_TOK, DM, F.G, cid); EpiPlain E{(bf16_t*)(F.ws + WS_PP), DM};
        gemm_phase<EpiPlain, StaticOrder, true, true>(F.lds + RING_OFF, g, S, E, F.wave); } SEAM(16);
    if (IN(17)) { Gemm g{XB, (const bf16_t*)(F.ws + WS_WPG), M_TOK, DM, DM}; StaticOrder S; S.init(M_TOK, DM, F.G, cid); EpiPle E{F.out, (const bf16_t*)(F.ws + WS_PP), RS, RS2};
        gemm_phase<EpiPle, StaticOrder, false, true>(F.lds + RING_OFF, g, S, E, F.wave); } SEAM(17);
    if (IN(18)) { final_norm_phase(F); }
#undef IN
#undef SEAM
}

extern "C" void kernel_launch(void* const* d_in, const int* in_sizes, int n_in, void* d_out, int out_size, void* d_ws, size_t ws_size, hipStream_t stream) {
    static int grid = 0;
    if (grid == 0) {
        if (n_in != 30 || in_sizes[0] != M_TOK * DM || out_size != M_TOK * DM || ws_size < WS_END) { fprintf(stderr, "kernel_launch: unexpected shapes (n_in %d, in0 %d, out %d, ws %zu)\n", n_in, n_in > 0 ? in_sizes[0] : -1, out_size, ws_size); grid = -1; return; }
        int dev = 0, cus = 0, per_cu = 0;
        if (hipGetDevice(&dev) != hipSuccess || hipDeviceGetAttribute(&cus, hipDeviceAttributeMultiprocessorCount, dev) != hipSuccess) { grid = -1; return; }
        if (hipFuncSetAttribute((const void*)blk_fwd, hipFuncAttributeMaxDynamicSharedMemorySize, LDS_BYTES) != hipSuccess) { fprintf(stderr, "kernel_launch: hipFuncSetAttribute failed\n"); grid = -1; return; }
        if (hipOccupancyMaxActiveBlocksPerMultiprocessor(&per_cu, (const void*)blk_fwd, NWAVES * 64, LDS_BYTES) != hipSuccess || per_cu < 1) { fprintf(stderr, "kernel_launch: occupancy query says %d blocks per CU\n", per_cu); per_cu = 1; }
        (void)hipGetLastError();
        grid = cus;
        if (grid != 256) fprintf(stderr, "kernel_launch: %d CUs; the N = 1024 residual phases need a 256-workgroup grid\n", grid);
    }
    if (grid < 0) return;
    (void)hipMemsetAsync((char*)d_ws + WS_CTL, 0, CTL_ZERO_BYTES, stream);
    Args a{};
    for (int i = 0; i < 30; ++i) a.in[i] = (const float*)d_in[i];
    a.out = (float*)d_out; a.ws = (unsigned char*)d_ws;
    if (N_LAUNCHES == 1) {
        a.ph_lo = 0; a.ph_hi = NPHASE;
        void* kargs[] = {&a};
        hipError_t e = hipLaunchCooperativeKernel((const void*)blk_fwd, dim3(grid), dim3(NWAVES * 64), kargs, LDS_BYTES, stream);
        if (e != hipSuccess) { fprintf(stderr, "kernel_launch: cooperative launch failed: %s; plain launch instead\n", hipGetErrorString(e)); (void)hipGetLastError(); hipLaunchKernelGGL(blk_fwd, dim3(grid), dim3(NWAVES * 64), LDS_BYTES, stream, a); }
    } else {
        for (int li = 0; li < NPHASE; ++li) { a.ph_lo = li; a.ph_hi = li + 1; hipLaunchKernelGGL(blk_fwd, dim3(grid), dim3(NWAVES * 64), LDS_BYTES, stream, a); }
    }
}
```

```cpp
#include <hip/hip_runtime.h>
#include <cstdio>
#include <cstdint>
__device__ __forceinline__ int hw_lane() { int l; asm volatile("v_mbcnt_lo_u32_b32 %0, -1, 0\n\tv_mbcnt_hi_u32_b32 %0, -1, %0" : "=v"(l)); return l; }
namespace pg8 {
#define PG8_LAS __attribute__((address_space(3)))
typedef unsigned short bf16_t;
typedef short bf16x8 __attribute__((ext_vector_type(8)));
typedef float f32x4 __attribute__((ext_vector_type(4)));
typedef unsigned u32x4 __attribute__((ext_vector_type(4)));
constexpr int BM = 256, BK = 64, HALF = 128, HTB = HALF * BK * 2  , STAGE_BYTES = 8 * HTB, NXCD = 8, WGM = 8;

__host__ __device__ __forceinline__ int lds_byte(int r, int c) { const int st = (r >> 4) * 2 + (c >> 5), rr = r & 15, cc = c & 31, ob = rr * 64 + cc * 2; return st * 1024 + (ob ^ (((ob >> 9) & 1) << 5)); }
__host__ __device__ __forceinline__ void stage_rc(int b, int& R, int& C) { const int st = b / 1024, sb = b % 1024, swz = sb ^ (((sb >> 9) & 1) << 5); R = (st >> 1) * 16 + swz / 64; C = (st & 1) * 32 + (swz % 64) / 2; }
__host__ __device__ __forceinline__ int perm32(int rho) { const int n = rho >> 4, i = rho & 15; return 8 * (i >> 2) + 4 * n + (i & 3); }

struct Unit { int pm, pn; };
struct Gemm { const bf16_t* A; const bf16_t* Bt; int M, N, K; };

struct StaticOrder {
    int nM, nN, nwg, G, c;
    __host__ __device__ void init(int M, int N, int G_, int c_) { nM = M / BM; nN = N / BM; nwg = nM * nN; G = G_; c = c_; }
    __host__ __device__ bool next(int i, Unit& u) const {
        const long L = (long)i * G + c; if (L >= nwg) return false;
        int wgid = (int)L; { const int q = nwg / NXCD, r = nwg % NXCD, xcd = wgid % NXCD, off = wgid / NXCD; wgid = (xcd < r ? xcd * (q + 1) : r * (q + 1) + (xcd - r) * q) + off; }
        const int nig = WGM * nN, gid = wgid / nig, fm = gid * WGM, gsz = (nM - fm) < WGM ? (nM - fm) : WGM;
        u.pm = fm + ((wgid % nig) % gsz); u.pn = (wgid % nig) / gsz; return true;
    }
    __device__ __forceinline__ void a_ready(const Unit&) const {}
    __device__ __forceinline__ void done(const Unit&) const {}
};

__device__ __forceinline__ unsigned cvt_pk_bf16(float lo, float hi) { unsigned r; asm volatile("v_cvt_pk_bf16_f32 %0, %1, %2" : "=v"(r) : "v"(lo), "v"(hi)); return r; }
typedef float f32x2 __attribute__((ext_vector_type(2)));
template <class Epi, class Sched, bool ALIGN_EPI = false, bool SP2 = false>
__device__ __forceinline__ void gemm_phase(PG8_LAS unsigned char* lds, const Gemm g, const Sched& S, const Epi& E, const int wid) {
    const int lane = hw_lane(), tid = wid * 64 + lane, wr = wid >> 2, wc = wid & 3, fr = lane & 15, fq = lane >> 4;
    const int K = g.K, nt = K / BK;
    unsigned voffA[2], voffB[2];
#pragma unroll
    for (int i = 0; i < 2; ++i) { int R, C; stage_rc(tid * 16 + i * 8192, R, C); const int Rb = Epi::PERM ? ((R & ~31) + perm32(R & 31)) : R;
        voffA[i] = (unsigned)(R * K + C) * 2u; voffB[i] = (unsigned)(Rb * K + C) * 2u; }
    const size_t kstep = (size_t)(BK * 2);
    const size_t hstep = (size_t)HALF * K * 2;
    const size_t tstep = 2 * hstep;
    const unsigned ldsw = (unsigned)wid * 1024u;
    const int aoff = lds_byte(wr * 64 + fr, fq * 8), boff = lds_byte(wc * 32 + fr, fq * 8);
#define PG8_SA(b, h) (((b) * 2 + (h)) * HTB)
#define PG8_SB(b, h) ((4 + (b) * 2 + (h)) * HTB)
#define PG8_STAGE(bufoff, gbase, voff) do { _Pragma("unroll") for (int _i = 0; _i < 2; ++_i) \
        __builtin_amdgcn_global_load_lds((const unsigned*)((const char*)(gbase) + (voff)[_i]), (PG8_LAS unsigned*)(lds + (bufoff) + ldsw + _i * 8192), 16, 0, 0); } while (0)
#define PG8_LDA(dst, b, h) do { _Pragma("unroll") for (int m = 0; m < 4; ++m) _Pragma("unroll") for (int k = 0; k < 2; ++k) dst[m][k] = *(const PG8_LAS bf16x8*)(lds + PG8_SA(b, h) + aoff + m * 2048 + k * 1024); } while (0)
#define PG8_LDB(dst, b, h) do { _Pragma("unroll") for (int n = 0; n < 2; ++n) _Pragma("unroll") for (int k = 0; k < 2; ++k) dst[n][k] = *(const PG8_LAS bf16x8*)(lds + PG8_SB(b, h) + boff + n * 2048 + k * 1024); } while (0)
#define PG8_MMA(ai, bj, At, Bt) do { __builtin_amdgcn_s_setprio(1); _Pragma("unroll") for (int m = 0; m < 4; ++m) _Pragma("unroll") for (int n = 0; n < 2; ++n) _Pragma("unroll") for (int k = 0; k < 2; ++k) \
        acc[ai][bj][m][n] = __builtin_amdgcn_mfma_f32_16x16x32_bf16(Bt[n][k], At[m][k], acc[ai][bj][m][n], 0, 0, 0); __builtin_amdgcn_s_setprio(0); } while (0)
#define PG8_WAIT_V(n) asm volatile("s_waitcnt vmcnt(" #n ")" ::: "memory")
#define PG8_WAIT_L(n) asm volatile("s_waitcnt lgkmcnt(" #n ")" ::: "memory")
#define PG8_BAR __builtin_amdgcn_s_barrier()
#define PG8_SCHED __builtin_amdgcn_sched_barrier(0)
    Unit cur, nxt; int ui = 0;
    if (!S.next(0, cur)) return;
    f32x4 acc[2][2][4][2];
#pragma unroll
    for (int a = 0; a < 2; ++a)
#pragma unroll
        for (int b = 0; b < 2; ++b)
#pragma unroll
            for (int m = 0; m < 4; ++m)
#pragma unroll
                for (int n = 0; n < 2; ++n) acc[a][b][m][n] = (f32x4){0.f, 0.f, 0.f, 0.f};
    bf16x8 At[4][2], B0[2][2], B1[2][2];
    const char* cA = (const char*)g.A + (size_t)cur.pm * tstep; const char* cB = (const char*)g.Bt + (size_t)cur.pn * tstep;
    S.a_ready(cur);
    if constexpr (SP2) {
        PG8_STAGE(PG8_SB(0, 0), cB, voffB); PG8_STAGE(PG8_SB(0, 1), cB + hstep, voffB); PG8_STAGE(PG8_SA(0, 0), cA, voffA); PG8_STAGE(PG8_SA(0, 1), cA + hstep, voffA);
        if (wr == 1) PG8_BAR;
        PG8_WAIT_V(2); PG8_BAR;
        PG8_STAGE(PG8_SB(1, 0), cB + kstep, voffB); PG8_STAGE(PG8_SA(1, 0), cA + kstep, voffA); PG8_STAGE(PG8_SB(1, 1), cB + hstep + kstep, voffB);
        PG8_WAIT_V(6); PG8_BAR;
    } else {
        PG8_STAGE(PG8_SB(0, 0), cB, voffB); PG8_STAGE(PG8_SA(0, 0), cA, voffA); PG8_STAGE(PG8_SB(0, 1), cB + hstep, voffB); PG8_STAGE(PG8_SA(0, 1), cA + hstep, voffA);
        if (wr == 1) PG8_BAR;
        PG8_WAIT_V(4); PG8_BAR;
        PG8_STAGE(PG8_SB(1, 0), cB + kstep, voffB); PG8_STAGE(PG8_SA(1, 0), cA + kstep, voffA); PG8_STAGE(PG8_SB(1, 1), cB + hstep + kstep, voffB);
        PG8_WAIT_V(6); PG8_BAR;
    }
    for (;;) {
        const bool has_next = S.next(ui + 1, nxt);
        const char* nA = has_next ? (const char*)g.A + (size_t)nxt.pm * tstep : cA; const char* nB = has_next ? (const char*)g.Bt + (size_t)nxt.pn * tstep : cB;
        for (int t = 0; t < nt; t += 2) {
            const bool last = (t == nt - 2);
            const char* a1 = cA + (size_t)(t + 1) * kstep;
            const char* a2 = last ? nA : cA + (size_t)(t + 2) * kstep; const char* b2 = last ? nB : cB + (size_t)(t + 2) * kstep;
            const char* a3 = a2 + kstep; const char* b3 = b2 + kstep;
            if (last && has_next) S.a_ready(nxt);
            if constexpr (SP2) {
            PG8_LDB(B0, 0, 0); PG8_LDB(B1, 0, 1); PG8_SCHED; PG8_LDA(At, 0, 0); PG8_STAGE(PG8_SA(1, 1), a1 + hstep, voffA);
            PG8_WAIT_V(8); PG8_WAIT_L(0); PG8_BAR; PG8_MMA(0, 0, At, B0); PG8_MMA(0, 1, At, B1); PG8_BAR; PG8_SCHED;
            PG8_LDA(At, 0, 1); PG8_STAGE(PG8_SB(0, 0), b2, voffB); PG8_STAGE(PG8_SB(0, 1), b2 + hstep, voffB); PG8_STAGE(PG8_SA(0, 0), a2, voffA);
            PG8_WAIT_V(8); PG8_WAIT_L(0); PG8_BAR; PG8_MMA(1, 0, At, B0); PG8_MMA(1, 1, At, B1); PG8_BAR; PG8_SCHED;
            PG8_LDB(B0, 1, 0); PG8_LDB(B1, 1, 1); PG8_SCHED; PG8_LDA(At, 1, 0); PG8_STAGE(PG8_SA(0, 1), a2 + hstep, voffA);
            PG8_WAIT_V(8); PG8_WAIT_L(0); PG8_BAR; PG8_MMA(0, 0, At, B0); PG8_MMA(0, 1, At, B1); PG8_BAR; PG8_SCHED;
            PG8_LDA(At, 1, 1); PG8_STAGE(PG8_SB(1, 0), b3, voffB); PG8_STAGE(PG8_SB(1, 1), b3 + hstep, voffB); PG8_STAGE(PG8_SA(1, 0), a3, voffA);
            PG8_WAIT_V(8); PG8_WAIT_L(0); PG8_BAR; PG8_MMA(1, 0, At, B0); PG8_MMA(1, 1, At, B1); PG8_BAR; PG8_SCHED;
            } else {
            PG8_LDB(B0, 0, 0); PG8_SCHED; PG8_LDA(At, 0, 0); PG8_STAGE(PG8_SA(1, 1), a1 + hstep, voffA);
            PG8_WAIT_L(8); PG8_BAR; PG8_WAIT_L(0); PG8_MMA(0, 0, At, B0); PG8_BAR; PG8_SCHED;
            PG8_LDB(B1, 0, 1); PG8_STAGE(PG8_SB(0, 0), b2, voffB);
            PG8_BAR; PG8_WAIT_L(0); PG8_MMA(0, 1, At, B1); PG8_BAR;
            PG8_LDA(At, 0, 1); PG8_STAGE(PG8_SA(0, 0), a2, voffA);
            PG8_BAR; PG8_WAIT_L(0); PG8_MMA(1, 0, At, B0); PG8_BAR; PG8_SCHED;
            PG8_STAGE(PG8_SB(0, 1), b2 + hstep, voffB);
            PG8_WAIT_V(6); PG8_BAR; PG8_MMA(1, 1, At, B1); PG8_BAR;
            PG8_LDB(B0, 1, 0); PG8_SCHED; PG8_LDA(At, 1, 0); PG8_STAGE(PG8_SA(0, 1), a2 + hstep, voffA);
            PG8_WAIT_L(8); PG8_BAR; PG8_WAIT_L(0); PG8_MMA(0, 0, At, B0); PG8_BAR; PG8_SCHED;
            PG8_LDB(B1, 1, 1); PG8_STAGE(PG8_SB(1, 0), b3, voffB);
            PG8_BAR; PG8_WAIT_L(0); PG8_MMA(0, 1, At, B1); PG8_BAR;
            PG8_LDA(At, 1, 1); PG8_STAGE(PG8_SA(1, 0), a3, voffA);
            PG8_BAR; PG8_WAIT_L(0); PG8_MMA(1, 0, At, B0); PG8_BAR; PG8_SCHED;
            PG8_STAGE(PG8_SB(1, 1), b3 + hstep, voffB);
            PG8_WAIT_V(6); PG8_BAR; PG8_MMA(1, 1, At, B1); PG8_BAR;
            }
        }
        if constexpr (ALIGN_EPI) { if (wr == 0) PG8_BAR; }
        if constexpr (!Epi::AFTER_DRAIN) { E(acc, cur, wr, wc, fr, fq); S.done(cur); }
        if (!has_next) break;
#pragma unroll
        for (int a = 0; a < 2; ++a)
#pragma unroll
            for (int b = 0; b < 2; ++b)
#pragma unroll
                for (int m = 0; m < 4; ++m)
#pragma unroll
                    for (int n = 0; n < 2; ++n) acc[a][b][m][n] = (f32x4){0.f, 0.f, 0.f, 0.f};
        cur = nxt; cA = nA; cB = nB; ++ui;
        if constexpr (ALIGN_EPI) { if (wr == 1) PG8_BAR; }
    }
    PG8_WAIT_V(0);
    if constexpr (!ALIGN_EPI) { if (wr == 0) PG8_BAR; }
    PG8_BAR;
    if constexpr (Epi::AFTER_DRAIN) { E.fused(acc, cur, wr, wc, fr, fq, lds, wid, lane); S.done(cur); }
#undef PG8_SA
#undef PG8_SB
#undef PG8_STAGE
#undef PG8_LDA
#undef PG8_LDB
#undef PG8_MMA
#undef PG8_WAIT_V
#undef PG8_WAIT_L
#undef PG8_BAR
#undef PG8_SCHED
}

constexpr int M_TOK = 16384, DM = 1024, FF = 2816, NIN = 6656, SEQ = 4096, NBATCH = 4;
constexpr int S5T = 32, S5NC = SEQ / S5T  , S5ROWS = NBATCH * S5NC  ;

struct BatchOrder {
    int nMg, nNg, per, total, G, c;
    __host__ __device__ void init(int ng, int nMg_, int nNg_, int G_, int c_) { nMg = nMg_; nNg = nNg_; per = nMg_ * nNg_; total = ng * per; G = G_; c = c_; }
    __host__ __device__ bool next(int i, Unit& u) const { const int L = i * G + c; if (L >= total) return false; const int g = L / per, r = L % per; u.pm = g * nMg + (r % nMg); u.pn = g * nNg + (r / nMg); return true; }
    __device__ __forceinline__ void a_ready(const Unit&) const {}
    __device__ __forceinline__ void done(const Unit&) const {}
};

typedef unsigned u32x2 __attribute__((ext_vector_type(2)));
__device__ __forceinline__ float sigm(float z) { return __builtin_amdgcn_rcpf(1.f + __builtin_amdgcn_exp2f(-1.44269504f * z)); }
__device__ __forceinline__ float bf_lo(unsigned w) { return __builtin_bit_cast(float, w << 16); }
__device__ __forceinline__ float bf_hi(unsigned w) { return __builtin_bit_cast(float, w & 0xffff0000u); }
__device__ __forceinline__ u32x4 pack8(const float (&v)[8]) { u32x4 w; w.x = cvt_pk_bf16(v[0], v[1]); w.y = cvt_pk_bf16(v[2], v[3]); w.z = cvt_pk_bf16(v[4], v[5]); w.w = cvt_pk_bf16(v[6], v[7]); return w; }
__device__ __forceinline__ void unpack8(const u32x4 w, float (&v)[8]) { v[0] = bf_lo(w.x); v[1] = bf_hi(w.x); v[2] = bf_lo(w.y); v[3] = bf_hi(w.y); v[4] = bf_lo(w.z); v[5] = bf_hi(w.z); v[6] = bf_lo(w.w); v[7] = bf_hi(w.w); }
__device__ __forceinline__ void row_scales(const float* RS, int row0, float (&r)[2][4]) {
#pragma unroll
    for (int ai = 0; ai < 2; ++ai)
#pragma unroll
        for (int m = 0; m < 4; ++m) { const f32x4 p = *(const f32x4*)(RS + (size_t)(row0 + ai * HALF + m * 16) * 4); r[ai][m] = __builtin_amdgcn_rsqf(((p.x + p.y) + (p.z + p.w)) * (1.0f / 1024.0f) + 1e-6f); }
}

struct EpiSwiglu {
    static constexpr bool PERM = true, AFTER_DRAIN = false;
    bf16_t* HID; const float* RS;
    __device__ __forceinline__ void operator()(const f32x4 (&acc)[2][2][4][2], const Unit& u, int wr, int wc, int fr, int fq) const {
        const int row0 = u.pm * BM + wr * 64 + fr, ch0 = u.pn * HALF + wc * 32 + 8 * fq;
        float r[2][4]; row_scales(RS, row0, r);
#pragma unroll
        for (int ai = 0; ai < 2; ++ai)
#pragma unroll
            for (int m = 0; m < 4; ++m) { const float rr = r[ai][m]; float h[8];
#pragma unroll
                for (int n = 0; n < 2; ++n)
#pragma unroll
                    for (int e = 0; e < 4; ++e) { const float g = acc[ai][0][m][n][e] * rr, up = acc[ai][1][m][n][e] * rr; h[4 * n + e] = g * sigm(g) * up; }
                *(u32x4*)(HID + (size_t)(row0 + ai * HALF + m * 16) * FF + ch0) = pack8(h); }
    }
};

struct EpiResid {
    static constexpr bool PERM = false, AFTER_DRAIN = true;
    const float* res; float* H; bf16_t* XB; float* RSout;
    __device__ __forceinline__ void fused(f32x4 (&acc)[2][2][4][2], const Unit& u, int wr, int wc, int fr, int fq, PG8_LAS unsigned char* lds, int wid, int lane) const {
        PG8_LAS float* PS = (PG8_LAS float*)lds;
        const int col0 = u.pn * BM + wc * 32 + 4 * fq;
#pragma unroll
        for (int ai = 0; ai < 2; ++ai)
#pragma unroll
            for (int m = 0; m < 4; ++m) { const int rl = ai * HALF + wr * 64 + m * 16 + fr; const size_t off = (size_t)(u.pm * BM + rl) * DM + col0; float s = 0.f;
#pragma unroll
                for (int bj = 0; bj < 2; ++bj)
#pragma unroll
                    for (int n = 0; n < 2; ++n) { const f32x4 b = *(const f32x4*)(res + off + bj * HALF + n * 16); const f32x4 v = b + acc[ai][bj][m][n];
                        *(f32x4*)(H + off + bj * HALF + n * 16) = v; u32x2 w; w.x = cvt_pk_bf16(v[0], v[1]); w.y = cvt_pk_bf16(v[2], v[3]); *(u32x2*)(XB + off + bj * HALF + n * 16) = w;
                        s += (v[0] * v[0] + v[1] * v[1]) + (v[2] * v[2] + v[3] * v[3]); }
                s += __shfl_xor(s, 16); s += __shfl_xor(s, 32);
                if (fq == 0) PS[rl * 4 + wc] = s; }
        asm volatile("s_waitcnt lgkmcnt(0)" ::: "memory"); __builtin_amdgcn_s_barrier(); asm volatile("" ::: "memory");
        const int tid = wid * 64 + lane;
        if (tid < 256) { const f32x4 p = *(const PG8_LAS f32x4*)(PS + tid * 4); RSout[(size_t)(u.pm * BM + tid) * 4 + u.pn] = (p.x + p.y) + (p.z + p.w); }
    }
};

struct EpiPle {
    static constexpr bool PERM = false, AFTER_DRAIN = true;
    float* H; const bf16_t* PP; const float* RS; float* RSout;
    __device__ __forceinline__ void fused(f32x4 (&acc)[2][2][4][2], const Unit& u, int wr, int wc, int fr, int fq, PG8_LAS unsigned char* lds, int wid, int lane) const {
        PG8_LAS float* PS = (PG8_LAS float*)lds;
        const int col0 = u.pn * BM + wc * 32 + 4 * fq;
        float r[2][4]; row_scales(RS, u.pm * BM + wr * 64 + fr, r);
#pragma unroll
        for (int ai = 0; ai < 2; ++ai)
#pragma unroll
            for (int m = 0; m < 4; ++m) { const int rl = ai * HALF + wr * 64 + m * 16 + fr; const size_t off = (size_t)(u.pm * BM + rl) * DM + col0; float s = 0.f; const float rr = r[ai][m];
#pragma unroll
                for (int bj = 0; bj < 2; ++bj)
#pragma unroll
                    for (int n = 0; n < 2; ++n) { const f32x4 b = *(const f32x4*)(H + off + bj * HALF + n * 16); const u32x2 pw = *(const u32x2*)(PP + off + bj * HALF + n * 16); const f32x4 a = acc[ai][bj][m][n];
                        f32x4 v; v[0] = b[0] + sigm(a[0] * rr) * bf_lo(pw.x); v[1] = b[1] + sigm(a[1] * rr) * bf_hi(pw.x); v[2] = b[2] + sigm(a[2] * rr) * bf_lo(pw.y); v[3] = b[3] + sigm(a[3] * rr) * bf_hi(pw.y);
                        *(f32x4*)(H + off + bj * HALF + n * 16) = v; s += (v[0] * v[0] + v[1] * v[1]) + (v[2] * v[2] + v[3] * v[3]); }
                s += __shfl_xor(s, 16); s += __shfl_xor(s, 32);
                if (fq == 0) PS[rl * 4 + wc] = s; }
        asm volatile("s_waitcnt lgkmcnt(0)" ::: "memory"); __builtin_amdgcn_s_barrier(); asm volatile("" ::: "memory");
        const int tid = wid * 64 + lane;
        if (tid < 256) { const f32x4 p = *(const PG8_LAS f32x4*)(PS + tid * 4); RSout[(size_t)(u.pm * BM + tid) * 4 + u.pn] = (p.x + p.y) + (p.z + p.w); }
    }
};

struct EpiProj {
    static constexpr bool PERM = true, AFTER_DRAIN = false;
    int pn_off; const float* RS; bf16_t* S5IN; bf16_t* Q; unsigned short* G16; bf16_t* I; bf16_t* O; const float* RINV; const float* hg_gain; bf16_t* GA; bf16_t* GB; const float* LB;
    __device__ __forceinline__ void operator()(const f32x4 (&acc)[2][2][4][2], const Unit& u, int wr, int wc, int fr, int fq) const {
        const int pnabs = u.pn + pn_off, row0 = u.pm * BM + wr * 64 + fr;
        const int kind = pnabs < 2 ? 0 : ((pnabs - 2) >> 2) + 1;
        const int cb = (kind == 0 ? pnabs * BM : ((pnabs - 2) & 3) * BM) + wc * 32 + 8 * fq;
        float r[2][4]; row_scales(RS, row0, r);
#pragma unroll
        for (int ai = 0; ai < 2; ++ai)
#pragma unroll
            for (int m = 0; m < 4; ++m) { const float rr = r[ai][m]; const int row = row0 + ai * HALF + m * 16;
#pragma unroll
                for (int bj = 0; bj < 2; ++bj) { const int c = cb + bj * HALF; float v[8];
#pragma unroll
                    for (int n = 0; n < 2; ++n)
#pragma unroll
                        for (int e = 0; e < 4; ++e) v[4 * n + e] = acc[ai][bj][m][n][e] * rr;
                    if (kind == 0) { *(u32x4*)(S5IN + ((size_t)(c >> 4) * M_TOK + row) * 16 + (c & 15)) = pack8(v); }
                    else if (kind == 1) {
#pragma unroll
                        for (int e = 0; e < 8; ++e) v[e] *= 0.08838834764831845f;
                        *(u32x4*)(Q + (size_t)row * DM + c) = pack8(v); }
                    else if (kind == 2) { const f32x4 l0 = *(const f32x4*)(LB + c), l1 = *(const f32x4*)(LB + c + 4); _Float16 h[8];
#pragma unroll
                        for (int e = 0; e < 8; ++e) { const float lb = e < 4 ? l0[e] : l1[e - 4]; h[e] = (_Float16)__logf(lb + (1.f - lb) * sigm(v[e])); }
                        u32x4 w; w.x = (unsigned)__builtin_bit_cast(unsigned short, h[0]) | ((unsigned)__builtin_bit_cast(unsigned short, h[1]) << 16); w.y = (unsigned)__builtin_bit_cast(unsigned short, h[2]) | ((unsigned)__builtin_bit_cast(unsigned short, h[3]) << 16);
                        w.z = (unsigned)__builtin_bit_cast(unsigned short, h[4]) | ((unsigned)__builtin_bit_cast(unsigned short, h[5]) << 16); w.w = (unsigned)__builtin_bit_cast(unsigned short, h[6]) | ((unsigned)__builtin_bit_cast(unsigned short, h[7]) << 16);
                        *(u32x4*)(G16 + (size_t)row * DM + c) = w; }
                    else if (kind == 3) { *(u32x4*)(I + (size_t)row * DM + c) = pack8(v); }
                    else if (kind == 4) { float o[8]; unpack8(*(const u32x4*)(O + (size_t)row * DM + c), o); const float* rp = RINV + ((size_t)row * 8 + (c >> 7)) * 8; const f32x4 p0 = *(const f32x4*)rp, p1 = *(const f32x4*)(rp + 4); const float ri = __builtin_amdgcn_rsqf((((p0.x + p0.y) + (p0.z + p0.w)) + ((p1.x + p1.y) + (p1.z + p1.w))) * (1.0f / 128.0f) + 1e-6f); const f32x4 g0 = *(const f32x4*)(hg_gain + c), g1 = *(const f32x4*)(hg_gain + c + 4);
#pragma unroll
                        for (int e = 0; e < 8; ++e) o[e] = o[e] * ri * (e < 4 ? g0[e] : g1[e - 4]) * (v[e] * sigm(v[e]));
                        *(u32x4*)(O + (size_t)row * DM + c) = pack8(o); }
                    else {
#pragma unroll
                        for (int e = 0; e < 8; ++e) v[e] = sigm(v[e]);
                        *(u32x4*)((kind == 5 ? GA : GB) + (size_t)row * DM + c) = pack8(v); }
                } }
    }
};

struct EpiGlu {
    static constexpr bool PERM = true, AFTER_DRAIN = false;
    bf16_t* MIX;
    __device__ __forceinline__ void operator()(const f32x4 (&acc)[2][2][4][2], const Unit& u, int wr, int wc, int fr, int fq) const {
        const int row0 = u.pm * BM + wr * 64 + fr, ch0 = u.pn * HALF + wc * 32 + 8 * fq;
#pragma unroll
        for (int ai = 0; ai < 2; ++ai)
#pragma unroll
            for (int m = 0; m < 4; ++m) { bf16_t* p = MIX + (size_t)(row0 + ai * HALF + m * 16) * DM + ch0; float ga[8], h[8]; unpack8(*(const u32x4*)p, ga);
#pragma unroll
                for (int n = 0; n < 2; ++n)
#pragma unroll
                    for (int e = 0; e < 4; ++e) h[4 * n + e] = ga[4 * n + e] * acc[ai][0][m][n][e] * sigm(acc[ai][1][m][n][e]);
                *(u32x4*)p = pack8(h); }
    }
};
struct EpiHgOut {
    static constexpr bool PERM = true, AFTER_DRAIN = false;
    bf16_t* MIX; const bf16_t* GB;
    __device__ __forceinline__ void operator()(const f32x4 (&acc)[2][2][4][2], const Unit& u, int wr, int wc, int fr, int fq) const {
        const int row0 = u.pm * BM + wr * 64 + fr, c0 = u.pn * BM + wc * 32 + 8 * fq;
#pragma unroll
        for (int ai = 0; ai < 2; ++ai)
#pragma unroll
            for (int m = 0; m < 4; ++m)
#pragma unroll
                for (int bj = 0; bj < 2; ++bj) { const size_t off = (size_t)(row0 + ai * HALF + m * 16) * DM + c0 + bj * HALF; float a[8], b[8]; unpack8(*(const u32x4*)(MIX + off), a); unpack8(*(const u32x4*)(GB + off), b);
#pragma unroll
                    for (int n = 0; n < 2; ++n)
#pragma unroll
                        for (int e = 0; e < 4; ++e) a[4 * n + e] += b[4 * n + e] * acc[ai][bj][m][n][e];
                    *(u32x4*)(MIX + off) = pack8(a); }
    }
};
struct EpiPlain {
    static constexpr bool PERM = true, AFTER_DRAIN = false;
    bf16_t* O; int ldc;
    __device__ __forceinline__ void operator()(const f32x4 (&acc)[2][2][4][2], const Unit& u, int wr, int wc, int fr, int fq) const {
        const int row0 = u.pm * BM + wr * 64 + fr, c0 = u.pn * BM + wc * 32 + 8 * fq;
#pragma unroll
        for (int ai = 0; ai < 2; ++ai)
#pragma unroll
            for (int m = 0; m < 4; ++m)
#pragma unroll
                for (int bj = 0; bj < 2; ++bj) { float v[8];
#pragma unroll
                    for (int n = 0; n < 2; ++n)
#pragma unroll
                        for (int e = 0; e < 4; ++e) v[4 * n + e] = acc[ai][bj][m][n][e];
                    *(u32x4*)(O + (size_t)(row0 + ai * HALF + m * 16) * ldc + c0 + bj * HALF) = pack8(v); }
    }
};
struct EpiS5a {
    static constexpr bool PERM = true, AFTER_DRAIN = false;
    bf16_t* YS5; float* XL;
    __device__ __forceinline__ void operator()(const f32x4 (&acc)[2][2][4][2], const Unit& u, int wr, int wc, int fr, int fq) const {
        const int g = u.pm >> 1, pml = u.pm & 1, pnl = u.pn - 3 * g;
#pragma unroll
        for (int ai = 0; ai < 2; ++ai)
#pragma unroll
            for (int m = 0; m < 4; ++m) { const int R = pml * BM + ai * HALF + wr * 64 + m * 16 + fr;
#pragma unroll
                for (int bj = 0; bj < 2; ++bj) { float v[8];
#pragma unroll
                    for (int n = 0; n < 2; ++n)
#pragma unroll
                        for (int e = 0; e < 4; ++e) v[4 * n + e] = acc[ai][bj][m][n][e];
                    const int cl = bj * HALF + wc * 32 + 8 * fq;
                    if (pnl < 2) { const int ci = pnl * BM + cl, t = ci >> 4, ho = ci & 15; *(u32x4*)(YS5 + ((size_t)R * S5T + t) * 512 + g * 16 + ho) = pack8(v); }
                    else if (bj == 0) { float* p = XL + ((size_t)(g * S5ROWS + R)) * 128 + cl; *(f32x4*)p = (f32x4){v[0], v[1], v[2], v[3]}; *(f32x4*)(p + 4) = (f32x4){v[4], v[5], v[6], v[7]}; }
                } }
    }
};
struct EpiS5b {
    static constexpr bool PERM = true, AFTER_DRAIN = false;
    bf16_t* YS5;
    __device__ __forceinline__ void operator()(const f32x4 (&acc)[2][2][4][2], const Unit& u, int wr, int wc, int fr, int fq) const {
        const int g = u.pm >> 1, pml = u.pm & 1, pnl = u.pn & 1;
#pragma unroll
        for (int ai = 0; ai < 2; ++ai)
#pragma unroll
            for (int m = 0; m < 4; ++m) { const int R = pml * BM + ai * HALF + wr * 64 + m * 16 + fr;
#pragma unroll
                for (int bj = 0; bj < 2; ++bj) { const int ci = pnl * BM + bj * HALF + wc * 32 + 8 * fq, t = ci >> 4, ho = ci & 15; bf16_t* p = YS5 + ((size_t)R * S5T + t) * 512 + g * 16 + ho; float y[8]; unpack8(*(const u32x4*)p, y);
#pragma unroll
                    for (int n = 0; n < 2; ++n)
#pragma unroll
                        for (int e = 0; e < 4; ++e) { const float x = y[4 * n + e] + acc[ai][bj][m][n][e]; y[4 * n + e] = x * sigm(1.5957691216f * (x + 0.044715f * x * x * x)); }
                    *(u32x4*)p = pack8(y); } }
    }
};
}

constexpr int NWAVES = 8;
#ifndef MK_N_LAUNCHES
#define MK_N_LAUNCHES 1
#endif
constexpr int NPHASE = 19;
constexpr int N_LAUNCHES = MK_N_LAUNCHES;
using pg8::M_TOK; using pg8::DM; using pg8::FF; using pg8::NIN; using pg8::SEQ; using pg8::NBATCH; using pg8::S5T; using pg8::S5NC; using pg8::S5ROWS;
constexpr float NORM_EPS = 1e-6f;

constexpr size_t MiB = 1u << 20, KiB = 1u << 10;
constexpr size_t WS_CTL = 0, CTL_ZERO_BYTES = 1 * MiB;
constexpr size_t WS_W1GU = 1 * MiB, WS_W1D = 12 * MiB, WS_WIN = WS_W1D + 5632 * KiB, WS_WGLU = WS_WIN + 13 * MiB, WS_WHG = WS_WGLU + 2 * MiB, WS_WM = WS_WHG + 2 * MiB,
                 WS_W2GU = WS_WM + 2 * MiB, WS_W2D = WS_W2GU + 11 * MiB, WS_WPG = WS_W2D + 5632 * KiB, WS_WPP = WS_WPG + 2 * MiB;
static_assert(WS_WPP + 512 * KiB <= 56 * MiB, "weights");
constexpr size_t WS_TOEP = 56 * MiB;
constexpr size_t WS_CT = 80 * MiB;
constexpr size_t WS_RS = 88 * MiB, WS_RS2 = WS_RS + 256 * KiB, WS_RINV = WS_RS + 512 * KiB, WS_LB = 89 * MiB, WS_LAMT = WS_LB + 4 * KiB;
constexpr size_t WS_XB = 90 * MiB;
constexpr size_t WS_R = 122 * MiB;
constexpr size_t WS_HID = WS_R;
constexpr size_t WS_YS5 = WS_R, WS_S5IN = WS_R + 16 * MiB, WS_XL = WS_R + 32 * MiB, WS_XP = WS_R + 40 * MiB;
constexpr size_t WS_Q = WS_R + 16 * MiB, WS_G16 = WS_R + 48 * MiB, WS_I = WS_R + 80 * MiB;
constexpr size_t WS_PB = WS_R + 112 * MiB;
constexpr size_t WS_PP = WS_R;
constexpr size_t WS_DF = WS_PB + 8 * MiB;
constexpr size_t WS_RPART = WS_DF + 1 * MiB;
constexpr size_t WS_END = WS_RPART + 4 * MiB;
static_assert(WS_END <= 256 * MiB, "d_ws map");
constexpr int CW_BAR = 4096;

constexpr int RING_OFF = 0, RING_BYTES = 131072;
constexpr int LDS_BYTES = 163840;
constexpr int LDSCTL_OFF = LDS_BYTES - 1024, MISC_OFF = LDSCTL_OFF + 320;

#define GAS __attribute__((address_space(1)))
#define LAS __attribute__((address_space(3)))
typedef unsigned short bf16;
typedef unsigned v4u __attribute__((ext_vector_type(4)));
typedef unsigned v2u __attribute__((ext_vector_type(2)));
typedef float f32x4 __attribute__((ext_vector_type(4)));
typedef float f32x2 __attribute__((ext_vector_type(2)));
typedef short bf16x8 __attribute__((ext_vector_type(8)));
typedef short s16x4 __attribute__((ext_vector_type(4)));
typedef GAS unsigned gu32;
#define RLX_AGENT __ATOMIC_RELAXED, __HIP_MEMORY_SCOPE_AGENT
#define LDS_WAIT() asm volatile("s_waitcnt lgkmcnt(0)" ::: "memory")
#define VM_WAIT() asm volatile("s_waitcnt vmcnt(0)" ::: "memory")
__device__ __forceinline__ unsigned f2bf(float f) { unsigned u = __builtin_bit_cast(unsigned, f); return (u + 0x7fffu + ((u >> 16) & 1u)) >> 16; }
__device__ __forceinline__ unsigned pk2(float lo, float hi) { return f2bf(lo) | (f2bf(hi) << 16); }
__device__ __forceinline__ float bflo(unsigned w) { return __builtin_bit_cast(float, w << 16); }
__device__ __forceinline__ float bfhi(unsigned w) { return __builtin_bit_cast(float, w & 0xffff0000u); }
#define XB_TMO      128
#define XB_XCNT(j)  (256  + 64 * (j))
#define XB_XSUB(j)  (1280 + 64 * (j))
#define XB_XGEN(j)  (2304 + 64 * (j))
#define XB_TOP      3328
#define XB_TOPGEN   3392
#define XCD_BAR_WORDS 3456
#define XB_SPIN_CAP (1u << 18)

__device__ __forceinline__ unsigned xb_ld(unsigned* p)              { return __hip_atomic_load(p, __ATOMIC_RELAXED, __HIP_MEMORY_SCOPE_AGENT); }
__device__ __forceinline__ unsigned xb_add(unsigned* p, unsigned v) { return __hip_atomic_fetch_add(p, v, __ATOMIC_RELAXED, __HIP_MEMORY_SCOPE_AGENT); }
__device__ __forceinline__ unsigned xb_xcc_id() { return (unsigned)__builtin_amdgcn_s_getreg((3 << 11) | 20) & 0xFu; }
#define XB_SPIN(cond, bar) do { unsigned _sp = 0; while (cond) { __builtin_amdgcn_s_sleep(1); \
    if ((++_sp & 255u) == 0u) { if (xb_ld(&(bar)[XB_TMO])) break; if (_sp > XB_SPIN_CAP) { atomicAdd(&(bar)[XB_TMO], 1u); break; } } } } while (0)

struct XcdBarrier {
    unsigned* bar; unsigned x; int wave;
    volatile LAS unsigned* st;
};

__device__ __forceinline__ XcdBarrier xcd_barrier_post(unsigned* bar, volatile LAS unsigned* st) {
    XcdBarrier b; b.bar = bar; b.x = xb_xcc_id(); b.st = st;
    if (threadIdx.x == 0) (void)xb_add(&bar[XB_XCNT(b.x)], 1u);
    return b;
}
__device__ __forceinline__ void xcd_barrier_complete(unsigned* bar, unsigned x, unsigned& nloc, unsigned& nx) {
    const unsigned G = gridDim.x * gridDim.y * gridDim.z;
    unsigned sum, cnt, mine, sp = 0u;
    for (;;) {
        sum = 0u; cnt = 0u; mine = 0u;
#pragma unroll
        for (unsigned j = 0; j < 16; ++j) { const unsigned c = xb_ld(&bar[XB_XCNT(j)]); sum += c; cnt += (c > 0u) ? 1u : 0u; mine = (j == x) ? c : mine; }
        if (sum == G) break;
        __builtin_amdgcn_s_sleep(1);
        if ((++sp & 255u) == 0u) { if (xb_ld(&bar[XB_TMO])) break; if (sp > XB_SPIN_CAP) { atomicAdd(&bar[XB_TMO], 1u); break; } }
    }
    nloc = mine > 0u ? mine : 1u; nx = cnt > 0u ? cnt : 1u;
}

__device__ __forceinline__ void xcd_barrier(const XcdBarrier& b) {
    asm volatile("s_waitcnt vmcnt(0)" ::: "memory");
    __syncthreads();
    if (b.wave == 0 && hw_lane() == 0) {
        unsigned* bar = b.bar;
        __builtin_amdgcn_s_waitcnt(0);
        unsigned nloc = b.st[0], nx = b.st[1];
        if (nloc == 0u) { xcd_barrier_complete(bar, b.x, nloc, nx); b.st[0] = nloc; b.st[1] = nx; }
        const unsigned old = xb_add(&bar[XB_XSUB(b.x)], 1u);
        const unsigned gen = old / nloc;
        if (old + 1u == (gen + 1u) * nloc) {
            __builtin_amdgcn_fence(__ATOMIC_RELEASE, "agent");
            asm volatile("s_waitcnt vmcnt(0)" ::: "memory");
            const unsigned og = xb_add(&bar[XB_TOP], 1u);
            const unsigned tg = og / nx;
            if (og + 1u == (tg + 1u) * nx) xb_add(&bar[XB_TOPGEN], 1u);
            else XB_SPIN(xb_ld(&bar[XB_TOPGEN]) == tg, bar);
            __builtin_amdgcn_fence(__ATOMIC_ACQUIRE, "agent");
            xb_add(&bar[XB_XGEN(b.x)], 1u);
            asm volatile("s_waitcnt vmcnt(0)" ::: "memory");
        } else {
            XB_SPIN(xb_ld(&bar[XB_XGEN(b.x)]) == gen, bar);
            __builtin_amdgcn_fence(__ATOMIC_ACQUIRE, "agent");
            asm volatile("s_waitcnt vmcnt(0)" ::: "memory");
        }
    }
    __syncthreads();
}

struct Frame {
    LAS unsigned char* lds;
    volatile LAS unsigned* MISC;
    gu32* ctl;
    int wave;
    int vcu, G;
    const float* in[30]; float* out; unsigned char* ws;
};
enum { IN_X = 0, IN_P, IN_FFN1_NORM, IN_FFN1_WG, IN_FFN1_WU, IN_FFN1_WD, IN_MIX_NORM, IN_WIN, IN_LAM_RE, IN_LAM_IM, IN_LOG_DT, IN_B_RE, IN_B_IM, IN_C_RE, IN_C_IM, IN_S5D, IN_GLU_VAL, IN_GLU_GATE,
       IN_HG_LB, IN_HG_NORM, IN_HG_WOUT, IN_WMERGE, IN_FFN2_NORM, IN_FFN2_WG, IN_FFN2_WU, IN_FFN2_WD, IN_PLE_NORM, IN_PLE_WG, IN_PLE_WP, IN_FINAL_NORM };

__device__ __forceinline__ float wave_sum(float v) {
#pragma unroll
    for (int o = 1; o < 64; o <<= 1) v += __shfl_xor(v, o);
    return v;
}
__device__ __forceinline__ void p0_transpose_item(const float* W, int K, int N, bf16* WT, const float* gain, float scale, int mode, LAS float* scr, int item, int lane) {
    const int nblk = N / 32, kb = item / nblk, nb = item % nblk, k0 = 64 * kb, n0 = 32 * nb;
#pragma unroll 8
    for (int i = 0; i < 32; ++i) { const int kk = 2 * i + (lane >> 5); const float gs = gain ? gain[k0 + kk] * scale : scale; scr[kk * 33 + (lane & 31)] = W[(size_t)(k0 + kk) * N + n0 + (lane & 31)] * gs; }
    LDS_WAIT(); asm volatile("" ::: "memory");
    const int c = lane & 7;
    const int nr0 = (mode == 0) ? n0 : 256 * (n0 >> 7) + (n0 & 127) + (mode == 2 ? 128 : 0);
#pragma unroll
    for (int j = 0; j < 4; ++j) { const int n = (lane >> 3) + 8 * j; const LAS float* s = scr + (8 * c) * 33 + n;
        v4u o; o.x = pk2(s[0 * 33], s[1 * 33]); o.y = pk2(s[2 * 33], s[3 * 33]); o.z = pk2(s[4 * 33], s[5 * 33]); o.w = pk2(s[6 * 33], s[7 * 33]);
        *(GAS v4u*)(WT + (size_t)(nr0 + n) * K + k0 + 8 * c) = o; }
    LDS_WAIT(); asm volatile("" ::: "memory");
}
struct cplx { double re, im; };
__device__ __forceinline__ cplx cmul(cplx a, cplx b) { return {a.re * b.re - a.im * b.im, a.re * b.im + a.im * b.re}; }
__device__ __forceinline__ cplx ldc(const LAS double* p, int i) { cplx r; r.re = p[2 * i]; r.im = p[2 * i + 1]; return r; }
__device__ __forceinline__ void stc(LAS double* p, int i, cplx v) { p[2 * i] = v.re; p[2 * i + 1] = v.im; }

__device__ __forceinline__ void p0_s5_tables(Frame& F, int g, int j) {
    LAS f32x2* LP = (LAS f32x2*)(F.lds); LAS f32x2* BB = (LAS f32x2*)(F.lds + 16896); LAS f32x2* CC = (LAS f32x2*)(F.lds + 16896 + 8192); LAS float* KK = (LAS float*)(F.lds + 16896 + 8192 + 1024);
    const float* lam_re = F.in[IN_LAM_RE] + g * 64; const float* lam_im = F.in[IN_LAM_IM] + g * 64;
    const float* b_re = F.in[IN_B_RE] + g * 1024; const float* b_im = F.in[IN_B_IM] + g * 1024;
    const float* c_re = F.in[IN_C_RE] + g * 1024; const float* c_im = F.in[IN_C_IM] + g * 1024;
    const int tid = F.wave * 64 + hw_lane();
    if (tid < 64) {
        const int p = tid; const double lr = (double)lam_re[p], li = (double)lam_im[p]; const double dt = exp((double)F.in[IN_LOG_DT][g]);
        const double er = exp(lr * dt); const double sn = sin(li * dt), cs = cos(li * dt);
        const cplx lb = {er * cs, er * sn}; cplx pw = {1.0, 0.0};
        for (int k = 0; k <= 32; ++k) { LP[k * 64 + p] = (f32x2){(float)pw.re, (float)pw.im}; if (k == 32 && j == 0) { ((float*)(F.ws + WS_LAMT))[(g * 64 + p) * 2] = (float)pw.re; ((float*)(F.ws + WS_LAMT))[(g * 64 + p) * 2 + 1] = (float)pw.im; } pw = cmul(pw, lb); }
        const double den = lr * lr + li * li; const cplx num = {lb.re - 1.0, lb.im}; const cplx coef = {(num.re * lr + num.im * li) / den, (num.im * lr - num.re * li) / den};
        for (int h = 0; h < 16; ++h) { const cplx b = {(double)b_re[p * 16 + h], (double)b_im[p * 16 + h]}; const cplx bb = cmul(coef, b); BB[p * 16 + h] = (f32x2){(float)bb.re, (float)bb.im}; }
    } else if (tid < 192) { const int e = tid - 64, hol = e >> 6, p = e & 63; CC[e] = (f32x2){c_re[(2 * j + hol) * 64 + p], c_im[(2 * j + hol) * 64 + p]}; }
    LDS_WAIT(); __syncthreads();
    for (int e = tid; e < 32 * 32; e += 512) { const int k = e >> 5, hol = (e >> 4) & 1, hi = e & 15, ho = 2 * j + hol; float s = 0.f;
        for (int p = 0; p < 64; ++p) { const f32x2 c = CC[hol * 64 + p], l = LP[k * 64 + p], bb = BB[p * 16 + hi]; const float tr = l.x * bb.x - l.y * bb.y, ti = l.x * bb.y + l.y * bb.x; s += c.x * tr - c.y * ti; }
        if (k == 0 && ho == hi) s += F.in[IN_S5D][g * 16 + ho];
        KK[e] = s; }
    LDS_WAIT(); __syncthreads();
    bf16* TO = (bf16*)(F.ws + WS_TOEP) + (size_t)g * 768 * 512;
    for (int ch = tid; ch < 64 * 64; ch += 512) { const int rl = ch >> 6, cc = ch & 63, t = rl >> 1, hol = rl & 1, n = t * 16 + 2 * j + hol, s = cc >> 1, hi0 = (cc & 1) * 8; float v[8];
#pragma unroll
        for (int e = 0; e < 8; ++e) v[e] = (s <= t) ? KK[((t - s) * 2 + hol) * 16 + hi0 + e] : 0.f;
        v4u o; o.x = pk2(v[0], v[1]); o.y = pk2(v[2], v[3]); o.z = pk2(v[4], v[5]); o.w = pk2(v[6], v[7]);
        *(GAS v4u*)(TO + (size_t)n * 512 + cc * 8) = o; }
    for (int ch = tid; ch < 32 * 64; ch += 512) { const int rl = ch >> 6, cc = ch & 63, s = cc >> 1, hi0 = (cc & 1) * 8; float v[8]; int n;
        if (rl < 16) { n = 512 + 16 * j + rl; const int p = (n - 512) >> 1, ri = n & 1; const f32x2 l = LP[(31 - s) * 64 + p];
#pragma unroll
            for (int e = 0; e < 8; ++e) { const f32x2 bb = BB[p * 16 + hi0 + e]; v[e] = ri ? (l.x * bb.y + l.y * bb.x) : (l.x * bb.x - l.y * bb.y); } }
        else { n = 640 + 16 * j + (rl - 16);
#pragma unroll
            for (int e = 0; e < 8; ++e) v[e] = 0.f; }
        v4u o; o.x = pk2(v[0], v[1]); o.y = pk2(v[2], v[3]); o.z = pk2(v[4], v[5]); o.w = pk2(v[6], v[7]);
        *(GAS v4u*)(TO + (size_t)n * 512 + cc * 8) = o; }
    bf16* CT = (bf16*)(F.ws + WS_CT) + (size_t)g * 512 * 256;
    for (int ch = tid; ch < 64 * 32; ch += 512) { const int rl = ch >> 5, cc = ch & 31, t = rl >> 1, hol = rl & 1, n = t * 16 + 2 * j + hol; float v[8];
        if (cc < 16) {
#pragma unroll
            for (int e = 0; e < 4; ++e) { const int p = cc * 4 + e; const f32x2 c = CC[hol * 64 + p], l = LP[(t + 1) * 64 + p]; v[2 * e] = c.x * l.x - c.y * l.y; v[2 * e + 1] = -(c.x * l.y + c.y * l.x); } }
        else {
#pragma unroll
            for (int e = 0; e < 8; ++e) v[e] = 0.f; }
        v4u o; o.x = pk2(v[0], v[1]); o.y = pk2(v[2], v[3]); o.z = pk2(v[4], v[5]); o.w = pk2(v[6], v[7]);
        *(GAS v4u*)(CT + (size_t)n * 256 + cc * 8) = o; }
    LDS_WAIT(); __syncthreads();
}

__device__ __forceinline__ void p0_prologue(Frame& F) {
    if (F.vcu < 256) p0_s5_tables(F, F.vcu >> 3, F.vcu & 7);
    const int lane = hw_lane(), tid = F.wave * 64 + lane;
    if (F.vcu == 32 && tid < 256) {
        const float* hb = F.in[IN_HG_LB]; float* LB = (float*)(F.ws + WS_LB);
        for (int c = tid; c < 1024; c += 256) { const float a0 = hb[c], a1 = hb[1024 + c]; LB[c] = 1.f / (1.f + expf(a1 - a0)); }
    }
    LAS float* scr = (LAS float*)(F.lds + RING_OFF + F.wave * 16384);
    const int gw = F.vcu * NWAVES + F.wave, NGW = F.G * NWAVES;
    int base = 0;
#define P0_W(INW, KK_, NN_, OFF, GAINP, SCALE, MODE) { constexpr int ni = ((KK_) / 64) * ((NN_) / 32); int first = (gw - base) % NGW; if (first < 0) first += NGW; \
        for (int it = first; it < ni; it += NGW) p0_transpose_item(F.in[INW], KK_, NN_, (bf16*)(F.ws + (OFF)), GAINP, SCALE, MODE, scr, it, lane); base += ni; }
    P0_W(IN_FFN1_WG, 1024, 2816, WS_W1GU, F.in[IN_FFN1_NORM], 1.f, 1) P0_W(IN_FFN1_WU, 1024, 2816, WS_W1GU, F.in[IN_FFN1_NORM], 1.f, 2) P0_W(IN_FFN1_WD, 2816, 1024, WS_W1D, nullptr, 0.5f, 0)
    P0_W(IN_WIN, 1024, 6656, WS_WIN, F.in[IN_MIX_NORM], 1.f, 0) P0_W(IN_GLU_VAL, 512, 1024, WS_WGLU, nullptr, 1.f, 1) P0_W(IN_GLU_GATE, 512, 1024, WS_WGLU, nullptr, 1.f, 2)
    P0_W(IN_HG_WOUT, 1024, 1024, WS_WHG, nullptr, 1.f, 0) P0_W(IN_WMERGE, 1024, 1024, WS_WM, nullptr, 1.f, 0)
    P0_W(IN_FFN2_WG, 1024, 2816, WS_W2GU, F.in[IN_FFN2_NORM], 1.f, 1) P0_W(IN_FFN2_WU, 1024, 2816, WS_W2GU, F.in[IN_FFN2_NORM], 1.f, 2) P0_W(IN_FFN2_WD, 2816, 1024, WS_W2D, nullptr, 0.5f, 0)
    P0_W(IN_PLE_WG, 1024, 1024, WS_WPG, F.in[IN_PLE_NORM], 1.f, 0) P0_W(IN_PLE_WP, 256, 1024, WS_WPP, nullptr, 1.f, 0)
#undef P0_W
    const float* x = F.in[IN_X]; bf16* XB = (bf16*)(F.ws + WS_XB); float* RS = (float*)(F.ws + WS_RS);
    for (int m = gw; m < M_TOK; m += NGW) { const GAS f32x4* xr = (const GAS f32x4*)(x + (size_t)m * DM) + lane; f32x4 v[4]; float s = 0.f;
#pragma unroll
        for (int j = 0; j < 4; ++j) { v[j] = xr[64 * j]; s += (v[j].x * v[j].x + v[j].y * v[j].y) + (v[j].z * v[j].z + v[j].w * v[j].w); }
        s = wave_sum(s);
        GAS v2u* o8 = (GAS v2u*)(XB + (size_t)m * DM) + lane;
#pragma unroll
        for (int j = 0; j < 4; ++j) { v2u w; w.x = pk2(v[j].x, v[j].y); w.y = pk2(v[j].z, v[j].w); o8[64 * j] = w; }
        if (lane == 0) *(f32x4*)(RS + (size_t)m * 4) = (f32x4){s, 0.f, 0.f, 0.f}; }
    const float* pin = F.in[IN_P]; bf16* PB = (bf16*)(F.ws + WS_PB);
    for (size_t i = (size_t)gw * 64 + lane; i < (size_t)M_TOK * 256 / 4; i += (size_t)NGW * 64) { const f32x4 v = ((const GAS f32x4*)pin)[i]; v2u w; w.x = pk2(v.x, v.y); w.y = pk2(v.z, v.w); ((GAS v2u*)PB)[i] = w; }
}

__device__ __forceinline__ void s5_scan_phase(Frame& F) {
    const int idx = blockIdx.x * 512 + F.wave * 64 + hw_lane(); if (idx >= 32 * NBATCH * 64) return;
    const int g = idx >> 8, b = (idx >> 6) & 3, p = idx & 63;
    const float* XL = (const float*)(F.ws + WS_XL) + ((size_t)(g * S5ROWS + b * S5NC)) * 128 + 2 * p; unsigned* XP = (unsigned*)(F.ws + WS_XP) + ((size_t)(g * S5ROWS + b * S5NC)) * 128 + p;
    const f32x2 lt = *(const f32x2*)((const float*)(F.ws + WS_LAMT) + (g * 64 + p) * 2);
    float xr = 0.f, xi = 0.f;
#pragma unroll 8
    for (int c = 0; c < S5NC; ++c) { const f32x2 l = *(const f32x2*)(XL + (size_t)c * 128);
        XP[(size_t)c * 128] = pk2(xr, xi); XP[(size_t)c * 128 + 64] = 0u;
        const float nr = lt.x * xr - lt.y * xi + l.x, ni = lt.x * xi + lt.y * xr + l.y; xr = nr; xi = ni; }
}

__device__ __forceinline__ void final_norm_phase(Frame& F) {
    const int gw = F.vcu * NWAVES + F.wave, NGW = F.G * NWAVES; const float* RS2 = (const float*)(F.ws + WS_RS2); const float* fn = F.in[IN_FINAL_NORM]; const int lane = hw_lane();
    f32x4 gn[4];
#pragma unroll
    for (int j = 0; j < 4; ++j) gn[j] = ((const f32x4*)fn)[lane + 64 * j];
    for (int m = gw; m < M_TOK; m += NGW) { const f32x4 p = *(const f32x4*)(RS2 + (size_t)m * 4); const float r = 1.0f / sqrtf(((p.x + p.y) + (p.z + p.w)) * (1.0f / 1024.0f) + NORM_EPS);
        GAS f32x4* o = (GAS f32x4*)(F.out + (size_t)m * DM) + lane;
#pragma unroll
        for (int j = 0; j < 4; ++j) { f32x4 v = o[64 * j]; v = v * r * gn[j]; o[64 * j] = v; } }
}

constexpr int PA_GC = 0, PA_QT = 32768, PA_KT = PA_QT + 17408, PA_VV = PA_KT + 17408, PA_P = PA_VV + 17408, PA_TOT = PA_P + 9216, PA_GL = PA_TOT + 2048;
static_assert(PA_GL + 512 <= RING_BYTES, "hgrn pass A lds");
__device__ __forceinline__ float h2f(unsigned short h) { return (float)__builtin_bit_cast(_Float16, h); }
__device__ __forceinline__ void tr_frag2(unsigned addr, bf16x8& f0, bf16x8& f1) {
    s16x4 a, b, c, d;
    asm volatile("ds_read_b64_tr_b16 %0, %4\n\tds_read_b64_tr_b16 %1, %4 offset:1088\n\tds_read_b64_tr_b16 %2, %4 offset:8704\n\tds_read_b64_tr_b16 %3, %4 offset:9792\n\ts_waitcnt lgkmcnt(0)"
                 : "=&v"(a), "=&v"(b), "=&v"(c), "=&v"(d) : "v"(addr) : "memory");
    f0 = (bf16x8){a[0], a[1], a[2], a[3], b[0], b[1], b[2], b[3]}; f1 = (bf16x8){c[0], c[1], c[2], c[3], d[0], d[1], d[2], d[3]};
}
__device__ __forceinline__ void hgrn_pass_a(Frame& F) {
    const int lane = hw_lane(), w = F.wave, tid = w * 64 + lane, l15 = lane & 15, lg = lane >> 4;
    LAS unsigned char* L = F.lds;
    LAS float* GC = (LAS float*)(L + PA_GC); LAS float* TOT = (LAS float*)(L + PA_TOT); LAS float* GL = (LAS float*)(L + PA_GL);
    bf16* Qg = (bf16*)(F.ws + WS_Q); unsigned short* Gg = (unsigned short*)(F.ws + WS_G16); bf16* Ig = (bf16*)(F.ws + WS_I); bf16* OI = (bf16*)(F.ws + WS_TOEP); float* DF = (float*)(F.ws + WS_DF);
    const int s_ = tid >> 3, kb = tid & 7, ck = tid & 127, cgp = tid >> 7;
    const size_t laneoff = (size_t)lg * 1024 + l15 * 8;
    const unsigned trbase = (unsigned)(8 * lg + (l15 >> 2)) * 272u + (unsigned)(l15 & 3) * 8u;
    int u = F.vcu;
    v4u q0, q1, g0, g1, i0, i1;
    if (u < 2048) { const int bh = u >> 6, c = u & 63; const size_t off = ((size_t)(bh >> 3) * SEQ + c * 64 + s_) * DM + (bh & 7) * 128 + kb * 16;
        q0 = *(const GAS v4u*)(Qg + off); q1 = *(const GAS v4u*)(Qg + off + 8); g0 = *(const GAS v4u*)(Gg + off); g1 = *(const GAS v4u*)(Gg + off + 8); i0 = *(const GAS v4u*)(Ig + off); i1 = *(const GAS v4u*)(Ig + off + 8); }
#pragma unroll 1
    for (; u < 2048; u += F.G) {
        const int bh = u >> 6, c = u & 63; const size_t E0 = ((size_t)(bh >> 3) * SEQ + c * 64) * DM + (bh & 7) * 128;
        float qv[16], gv[16];
        { const unsigned qa[8] = {q0.x, q0.y, q0.z, q0.w, q1.x, q1.y, q1.z, q1.w}, ga[8] = {g0.x, g0.y, g0.z, g0.w, g1.x, g1.y, g1.z, g1.w};
#pragma unroll
          for (int j = 0; j < 8; ++j) { qv[2 * j] = bflo(qa[j]); qv[2 * j + 1] = bfhi(qa[j]); gv[2 * j] = h2f((unsigned short)(ga[j] & 0xffffu)); gv[2 * j + 1] = h2f((unsigned short)(ga[j] >> 16)); } }
#pragma unroll
        for (int j = 0; j < 4; ++j) *(LAS f32x4*)(GC + s_ * 128 + kb * 16 + 4 * j) = (f32x4){gv[4 * j], gv[4 * j + 1], gv[4 * j + 2], gv[4 * j + 3]};
        *(LAS v4u*)(L + PA_VV + s_ * 272 + kb * 32) = i0; *(LAS v4u*)(L + PA_VV + s_ * 272 + kb * 32 + 16) = i1;
        { const int un = u + F.G; if (un < 2048) { const int bh2 = un >> 6, c2 = un & 63; const size_t off = ((size_t)(bh2 >> 3) * SEQ + c2 * 64 + s_) * DM + (bh2 & 7) * 128 + kb * 16;
            q0 = *(const GAS v4u*)(Qg + off); q1 = *(const GAS v4u*)(Qg + off + 8); g0 = *(const GAS v4u*)(Gg + off); g1 = *(const GAS v4u*)(Gg + off + 8); i0 = *(const GAS v4u*)(Ig + off); i1 = *(const GAS v4u*)(Ig + off + 8); } }
        LDS_WAIT(); __builtin_amdgcn_s_barrier(); asm volatile("" ::: "memory");
        { float loc[16]; float run = 0.f;
#pragma unroll
          for (int j = 0; j < 16; ++j) { run += GC[(cgp * 16 + j) * 128 + ck]; loc[j] = run; }
          TOT[cgp * 128 + ck] = run;
          LDS_WAIT(); __builtin_amdgcn_s_barrier(); asm volatile("" ::: "memory");
          float off = 0.f;
#pragma unroll
          for (int gg = 0; gg < 3; ++gg) off += (gg < cgp) ? TOT[gg * 128 + ck] : 0.f;
#pragma unroll
          for (int j = 0; j < 16; ++j) GC[(cgp * 16 + j) * 128 + ck] = loc[j] + off;
          if (cgp == 3) { const float gl = loc[15] + off; GL[ck] = gl; DF[(size_t)u * 128 + ck] = __expf(gl); } }
        LDS_WAIT(); __builtin_amdgcn_s_barrier(); asm volatile("" ::: "memory");
        { float qt[16], kt[16];
#pragma unroll
          for (int j = 0; j < 16; ++j) { const float d = GC[s_ * 128 + kb * 16 + j] - GL[kb * 16 + j]; const float E = __expf(d), Ei = __expf(-d); const float kk = 1.f - __expf(gv[j]); qt[j] = qv[j] * E; kt[j] = kk * Ei; }
          v4u a, bq;
          a.x = pk2(qt[0], qt[1]); a.y = pk2(qt[2], qt[3]); a.z = pk2(qt[4], qt[5]); a.w = pk2(qt[6], qt[7]); bq.x = pk2(qt[8], qt[9]); bq.y = pk2(qt[10], qt[11]); bq.z = pk2(qt[12], qt[13]); bq.w = pk2(qt[14], qt[15]);
          *(LAS v4u*)(L + PA_QT + s_ * 272 + kb * 32) = a; *(LAS v4u*)(L + PA_QT + s_ * 272 + kb * 32 + 16) = bq;
          a.x = pk2(kt[0], kt[1]); a.y = pk2(kt[2], kt[3]); a.z = pk2(kt[4], kt[5]); a.w = pk2(kt[6], kt[7]); bq.x = pk2(kt[8], kt[9]); bq.y = pk2(kt[10], kt[11]); bq.z = pk2(kt[12], kt[13]); bq.w = pk2(kt[14], kt[15]);
          *(LAS v4u*)(L + PA_KT + s_ * 272 + kb * 32) = a; *(LAS v4u*)(L + PA_KT + s_ * 272 + kb * 32 + 16) = bq; }
        LDS_WAIT(); __builtin_amdgcn_s_barrier(); asm volatile("" ::: "memory");
        { const int tm = w >> 1;
#pragma unroll
          for (int jn = 0; jn < 2; ++jn) { const int tn = 2 * (w & 1) + jn; f32x4 sc = (f32x4){0.f, 0.f, 0.f, 0.f};
            if (tn <= tm) {
#pragma unroll
                for (int ks = 0; ks < 4; ++ks) { const bf16x8 a = *(const LAS bf16x8*)(L + PA_KT + (16 * tn + l15) * 272 + (32 * ks + 8 * lg) * 2); const bf16x8 bb = *(const LAS bf16x8*)(L + PA_QT + (16 * tm + l15) * 272 + (32 * ks + 8 * lg) * 2);
                    sc = __builtin_amdgcn_mfma_f32_16x16x32_bf16(a, bb, sc, 0, 0, 0); } }
            const int t = 16 * tm + l15, s0 = 16 * tn + 4 * lg; v2u pw; pw.x = pk2(s0 <= t ? sc[0] : 0.f, s0 + 1 <= t ? sc[1] : 0.f); pw.y = pk2(s0 + 2 <= t ? sc[2] : 0.f, s0 + 3 <= t ? sc[3] : 0.f);
            *(LAS v2u*)(L + PA_P + t * 144 + s0 * 2) = pw; } }
        bf16x8 vf0, vf1, kf0, kf1;
        tr_frag2((unsigned)(size_t)(L + PA_VV) + trbase + (unsigned)w * 32u, vf0, vf1);
        tr_frag2((unsigned)(size_t)(L + PA_KT) + trbase + (unsigned)w * 32u, kf0, kf1);
        *(GAS bf16x8*)(Ig + E0 + (size_t)(2 * w) * 4096 + laneoff) = vf0; *(GAS bf16x8*)(Ig + E0 + (size_t)(2 * w + 1) * 4096 + laneoff) = vf1;
        *(GAS bf16x8*)(Gg + E0 + (size_t)(2 * w) * 4096 + laneoff) = kf0; *(GAS bf16x8*)(Gg + E0 + (size_t)(2 * w + 1) * 4096 + laneoff) = kf1;
#pragma unroll
        for (int j = 0; j < 2; ++j) { const int f = 2 * w + j, tmq = f >> 2, iq = f & 3; const v2u lo = *(const LAS v2u*)(L + PA_QT + (16 * tmq + l15) * 272 + (32 * iq + 4 * lg) * 2), hi = *(const LAS v2u*)(L + PA_QT + (16 * tmq + l15) * 272 + (32 * iq + 16 + 4 * lg) * 2);
            v4u o; o.x = lo.x; o.y = lo.y; o.z = hi.x; o.w = hi.y; *(GAS v4u*)(Qg + E0 + (size_t)f * 4096 + laneoff) = o; }
        LDS_WAIT(); __builtin_amdgcn_s_barrier(); asm volatile("" ::: "memory");
#pragma unroll
        for (int tm = 0; tm < 4; ++tm) { f32x4 a4 = (f32x4){0.f, 0.f, 0.f, 0.f};
            { const bf16x8 pf = *(const LAS bf16x8*)(L + PA_P + (16 * tm + l15) * 144 + (8 * lg) * 2); a4 = __builtin_amdgcn_mfma_f32_16x16x32_bf16(vf0, pf, a4, 0, 0, 0); }
            if (tm >= 2) { const bf16x8 pf = *(const LAS bf16x8*)(L + PA_P + (16 * tm + l15) * 144 + (32 + 8 * lg) * 2); a4 = __builtin_amdgcn_mfma_f32_16x16x32_bf16(vf1, pf, a4, 0, 0, 0); }
            v2u ow; ow.x = pk2(a4[0], a4[1]); ow.y = pk2(a4[2], a4[3]); *(GAS v2u*)(OI + E0 + (size_t)(16 * tm + l15) * DM + 16 * w + 4 * lg) = ow; }
    }
}

constexpr int PB_QF = 0, PB_KTF = 16384, PB_VTF = 32768, PB_OI = 34816, PB_DF = 36864, PB_SLOT = 37376, PB_NSLOT = 4;
static_assert(PB_NSLOT * PB_SLOT <= LDSCTL_OFF, "hgrn pass B lds");
__device__ __forceinline__ void hgrn_pass_b(Frame& F) {
    const int bh = F.vcu >> 3; if (bh >= 32) return;
    const int lane = hw_lane(), l15 = lane & 15, lg = lane >> 4, w = F.vcu & 7, hw = F.wave, b = bh >> 3, h = bh & 7;
    LAS unsigned char* L = F.lds;
    const bf16* Qg = (const bf16*)(F.ws + WS_Q); const bf16* Kg = (const bf16*)(F.ws + WS_G16); const bf16* Vg = (const bf16*)(F.ws + WS_I); bf16* OI = (bf16*)(F.ws + WS_TOEP);
    const float* DF = (const float*)(F.ws + WS_DF); float* RPART = (float*)(F.ws + WS_RPART);
    const size_t laneoff = (size_t)lg * 1024 + l15 * 8;
    const size_t Eb = ((size_t)b * SEQ) * DM + h * 128;
    f32x4 S[8];
#pragma unroll
    for (int i = 0; i < 8; ++i) S[i] = (f32x4){0.f, 0.f, 0.f, 0.f};
#define PB_ISSUE(cc, SLOT) do { const int c_ = (cc) < SEQ / 64 ? (cc) : SEQ / 64 - 1; const size_t E0_ = Eb + (size_t)c_ * 64 * DM; LAS unsigned char* sl_ = L + (SLOT) * PB_SLOT; \
        _Pragma("unroll") for (int f_ = 0; f_ < 2; ++f_) { \
            __builtin_amdgcn_global_load_lds((const unsigned*)(Qg + E0_ + (size_t)(2 * hw + f_) * 4096 + laneoff), (LAS unsigned*)(sl_ + PB_QF + (2 * hw + f_) * 1024), 16, 0, 0); \
            __builtin_amdgcn_global_load_lds((const unsigned*)(Kg + E0_ + (size_t)(2 * hw + f_) * 4096 + laneoff), (LAS unsigned*)(sl_ + PB_KTF + (2 * hw + f_) * 1024), 16, 0, 0); } \
        if (hw < 2) __builtin_amdgcn_global_load_lds((const unsigned*)(Vg + E0_ + (size_t)(2 * w + hw) * 4096 + laneoff), (LAS unsigned*)(sl_ + PB_VTF + hw * 1024), 16, 0, 0); \
        else if (hw < 4) __builtin_amdgcn_global_load_lds((const unsigned*)(OI + E0_ + (size_t)(32 * (hw - 2) + (lane >> 1)) * DM + 16 * w + (lane & 1) * 8), (LAS unsigned*)(sl_ + PB_OI + (hw - 2) * 1024), 16, 0, 0); \
        else if (hw < 6) __builtin_amdgcn_global_load_lds((const unsigned*)(DF + ((size_t)bh * 64 + c_) * 128 + (hw - 4) * 64 + lane), (LAS unsigned*)(sl_ + PB_DF + (hw - 4) * 256), 4, 0, 0); } while (0)
    PB_ISSUE(0, 0); PB_ISSUE(1, 1); PB_ISSUE(2, 2);
#define PB_CHUNK(c, SLOT) do { \
        if (hw == 0) { if ((c) == 0) asm volatile("s_waitcnt vmcnt(10)" ::: "memory"); else asm volatile("s_waitcnt vmcnt(18)" ::: "memory"); }     \
        else if (hw < 6) asm volatile("s_waitcnt vmcnt(10)" ::: "memory"); else asm volatile("s_waitcnt vmcnt(8)" ::: "memory"); \
        asm volatile("s_waitcnt lgkmcnt(0)" ::: "memory"); \
        __builtin_amdgcn_s_barrier(); asm volatile("" ::: "memory");            \
        __builtin_amdgcn_sched_barrier(0); \
        PB_ISSUE((c) + 3, ((SLOT) + 3) & 3); \
        if (hw == 0) { \
        LAS unsigned char* sl = L + (SLOT) * PB_SLOT; \
        f32x4 acc[4]; \
        _Pragma("unroll") for (int tm = 0; tm < 4; ++tm) { const v2u oi = *(const LAS v2u*)(sl + PB_OI + (16 * tm + l15) * 32 + lg * 8); acc[tm] = (f32x4){bflo(oi.x), bfhi(oi.x), bflo(oi.y), bfhi(oi.y)}; } \
        bf16x8 Sf[4]; \
        _Pragma("unroll") for (int kt = 0; kt < 8; ++kt) { const f32x4 d = *(const LAS f32x4*)(sl + PB_DF + (16 * kt + 4 * lg) * 4); S[kt] = S[kt] * d; } \
        _Pragma("unroll") for (int i = 0; i < 4; ++i) { v4u u_; u_.x = pk2(S[2 * i][0], S[2 * i][1]); u_.y = pk2(S[2 * i][2], S[2 * i][3]); u_.z = pk2(S[2 * i + 1][0], S[2 * i + 1][1]); u_.w = pk2(S[2 * i + 1][2], S[2 * i + 1][3]); Sf[i] = __builtin_bit_cast(bf16x8, u_); } \
        _Pragma("unroll") for (int tm = 0; tm < 4; ++tm) \
            _Pragma("unroll") for (int i = 0; i < 4; ++i) { const bf16x8 qf = *(const LAS bf16x8*)(sl + PB_QF + (tm * 4 + i) * 1024 + lane * 16); acc[tm] = __builtin_amdgcn_mfma_f32_16x16x32_bf16(Sf[i], qf, acc[tm], 0, 0, 0); } \
        { const bf16x8 v0 = *(const LAS bf16x8*)(sl + PB_VTF + lane * 16), v1 = *(const LAS bf16x8*)(sl + PB_VTF + 1024 + lane * 16); \
          _Pragma("unroll") for (int kt = 0; kt < 8; ++kt) { const bf16x8 k0 = *(const LAS bf16x8*)(sl + PB_KTF + (2 * kt) * 1024 + lane * 16), k1 = *(const LAS bf16x8*)(sl + PB_KTF + (2 * kt + 1) * 1024 + lane * 16); \
              S[kt] = __builtin_amdgcn_mfma_f32_16x16x32_bf16(k0, v0, S[kt], 0, 0, 0); S[kt] = __builtin_amdgcn_mfma_f32_16x16x32_bf16(k1, v1, S[kt], 0, 0, 0); } } \
        _Pragma("unroll") for (int tm = 0; tm < 4; ++tm) { const f32x4 o = acc[tm]; const size_t row = (size_t)b * SEQ + (c) * 64 + 16 * tm + l15; v2u ow; ow.x = pk2(o[0], o[1]); ow.y = pk2(o[2], o[3]); \
            *(GAS v2u*)(OI + row * DM + h * 128 + 16 * w + 4 * lg) = ow; \
            float s = (o[0] * o[0] + o[1] * o[1]) + (o[2] * o[2] + o[3] * o[3]); s += __shfl_xor(s, 16); s += __shfl_xor(s, 32); \
            if (lg == 0) RPART[(row * 8 + h) * 8 + w] = s; } } } while (0)
#pragma unroll 1
    for (int c4 = 0; c4 < SEQ / 64; c4 += 4) { PB_CHUNK(c4, 0); PB_CHUNK(c4 + 1, 1); PB_CHUNK(c4 + 2, 2); PB_CHUNK(c4 + 3, 3); }
    asm volatile("s_waitcnt vmcnt(0) lgkmcnt(0)" ::: "memory");
#undef PB_CHUNK
#undef PB_ISSUE
}

struct Args { const float* in[30]; float* out; unsigned char* ws; int ph_lo, ph_hi; };
__global__ void __launch_bounds__(NWAVES * 64, 2) blk_fwd(Args args) {
    extern __shared__ __attribute__((aligned(16))) unsigned char lds[];
    Frame F;
    F.lds = (LAS unsigned char*)lds;
    F.MISC = (volatile LAS unsigned*)(F.lds + MISC_OFF);
    F.wave = __builtin_amdgcn_readfirstlane((int)threadIdx.x >> 6);
    F.G = gridDim.x; { const int bx = blockIdx.x; F.vcu = (F.G % 8 == 0) ? (bx % 8) * (F.G / 8) + bx / 8 : bx; }
    F.ws = args.ws; F.out = args.out; F.ctl = (gu32*)(args.ws + WS_CTL);
#pragma unroll
    for (int i = 0; i < 30; ++i) F.in[i] = args.in[i];
    for (int u = (int)threadIdx.x; u < (LDS_BYTES - LDSCTL_OFF) / 4; u += NWAVES * 64) ((LAS unsigned*)(F.lds + LDSCTL_OFF))[u] = 0u;
    __syncthreads();
    XcdBarrier bar; bar.bar = (unsigned*)(F.ctl + CW_BAR); bar.x = 0; bar.st = nullptr; bar.wave = F.wave;
    if (N_LAUNCHES == 1) { bar = xcd_barrier_post((unsigned*)(F.ctl + CW_BAR), F.MISC + 8); bar.wave = F.wave; }
    const int lo = args.ph_lo, hi = args.ph_hi;
#ifndef PROBE_REP
#define PROBE_REP -1
#endif
#ifndef PHASE_MASK
#define PHASE_MASK 0x7ffff
#endif
#define IN(k) ((((PHASE_MASK) >> (k)) & 1) && lo <= (k) && (k) < hi)
#define SEAM(k) do { if (IN(k) && IN((k) + 1)) xcd_barrier(bar); } while (0)
    using namespace pg8;
    bf16_t* const XB = (bf16_t*)(F.ws + WS_XB); float* const RS = (float*)(F.ws + WS_RS); float* const RS2 = (float*)(F.ws + WS_RS2);
    bf16_t* const HID = (bf16_t*)(F.ws + WS_HID); bf16_t* const WIN = (bf16_t*)(F.ws + WS_WIN);
    const int cid = (int)blockIdx.x;

    if (IN(0)) { if (PROBE_REP == 0) { p0_prologue(F); xcd_barrier(bar); } p0_prologue(F); } SEAM(0);
    if (IN(1)) { Gemm g{XB, (const bf16_t*)(F.ws + WS_W1GU), M_TOK, 2 * FF, DM}; StaticOrder S; S.init(M_TOK, 2 * FF, F.G, cid); EpiSwiglu E{HID, RS};
        gemm_phase<EpiSwiglu, StaticOrder, true, true>(F.lds + RING_OFF, g, S, E, F.wave); } SEAM(1);
    if (IN(2)) { Gemm g{HID, (const bf16_t*)(F.ws + WS_W1D), M_TOK, DM, FF}; StaticOrder S; S.init(M_TOK, DM, F.G, cid); EpiResid E{F.in[IN_X], F.out, XB, RS};
        gemm_phase<EpiResid, StaticOrder, false, true>(F.lds + RING_OFF, g, S, E, F.wave); } SEAM(2);
#define MK_EP(off) EpiProj EP{off, RS, (bf16_t*)(F.ws + WS_S5IN), (bf16_t*)(F.ws + WS_Q), (unsigned short*)(F.ws + WS_G16), (bf16_t*)(F.ws + WS_I), (bf16_t*)(F.ws + WS_TOEP), (const float*)(F.ws + WS_RPART), F.in[IN_HG_NORM], \
               (bf16_t*)(F.ws + WS_G16), (bf16_t*)(F.ws + WS_I), (const float*)(F.ws + WS_LB)}
    if (IN(3)) { Gemm g{XB, WIN, M_TOK, 512, DM}; StaticOrder S; S.init(M_TOK, 512, F.G, cid); MK_EP(0);
        gemm_phase<EpiProj, StaticOrder, true, true>(F.lds + RING_OFF, g, S, EP, F.wave); } SEAM(3);
    if (IN(4)) { Gemm g{(const bf16_t*)(F.ws + WS_S5IN), (const bf16_t*)(F.ws + WS_TOEP), 32 * S5ROWS, 32 * 768, 512}; BatchOrder S; S.init(32, 2, 3, F.G, cid); EpiS5a E{(bf16_t*)(F.ws + WS_YS5), (float*)(F.ws + WS_XL)};
        gemm_phase<EpiS5a, BatchOrder, true, true>(F.lds + RING_OFF, g, S, E, F.wave); } SEAM(4);
    if (IN(5)) { if (PROBE_REP == 5) { s5_scan_phase(F); xcd_barrier(bar); } s5_scan_phase(F); } SEAM(5);
    if (IN(6)) { Gemm g{(const bf16_t*)(F.ws + WS_XP), (const bf16_t*)(F.ws + WS_CT), 32 * S5ROWS, 32 * 512, 256}; BatchOrder S; S.init(32, 2, 2, F.G, cid); EpiS5b E{(bf16_t*)(F.ws + WS_YS5)};
        gemm_phase<EpiS5b, BatchOrder, true, true>(F.lds + RING_OFF, g, S, E, F.wave); } SEAM(6);
    if (IN(7)) { Gemm g{XB, WIN + (size_t)512 * DM, M_TOK, 3072, DM}; StaticOrder S; S.init(M_TOK, 3072, F.G, cid); MK_EP(2);
        gemm_phase<EpiProj, StaticOrder, true, true>(F.lds + RING_OFF, g, S, EP, F.wave); } SEAM(7);
    if (IN(8)) { hgrn_pass_a(F); } SEAM(8);
    if (IN(9)) { hgrn_pass_b(F); } SEAM(9);
    if (IN(10)) { Gemm g{XB, WIN + (size_t)3584 * DM, M_TOK, 3072, DM}; StaticOrder S; S.init(M_TOK, 3072, F.G, cid); MK_EP(14);
        gemm_phase<EpiProj, StaticOrder, true, true>(F.lds + RING_OFF, g, S, EP, F.wave); } SEAM(10);
    if (IN(11)) { Gemm g{(const bf16_t*)(F.ws + WS_YS5), (const bf16_t*)(F.ws + WS_WGLU), M_TOK, 2048, 512}; StaticOrder S; S.init(M_TOK, 2048, F.G, cid); EpiGlu E{(bf16_t*)(F.ws + WS_G16)};
        gemm_phase<EpiGlu, StaticOrder, true, true>(F.lds + RING_OFF, g, S, E, F.wave); } SEAM(11);
    if (IN(12)) { Gemm g{(const bf16_t*)(F.ws + WS_TOEP), (const bf16_t*)(F.ws + WS_WHG), M_TOK, DM, DM}; StaticOrder S; S.init(M_TOK, DM, F.G, cid); EpiHgOut E{(bf16_t*)(F.ws + WS_G16), (const bf16_t*)(F.ws + WS_I)};
        gemm_phase<EpiHgOut, StaticOrder, true, true>(F.lds + RING_OFF, g, S, E, F.wave); } SEAM(12);
    if (IN(13)) { Gemm g{(const bf16_t*)(F.ws + WS_G16), (const bf16_t*)(F.ws + WS_WM), M_TOK, DM, DM}; StaticOrder S; S.init(M_TOK, DM, F.G, cid); EpiResid E{F.out, F.out, XB, RS};
        gemm_phase<EpiResid, StaticOrder, false, true>(F.lds + RING_OFF, g, S, E, F.wave); } SEAM(13);
    if (IN(14)) { Gemm g{XB, (const bf16_t*)(F.ws + WS_W2GU), M_TOK, 2 * FF, DM}; StaticOrder S; S.init(M_TOK, 2 * FF, F.G, cid); EpiSwiglu E{HID, RS};
        gemm_phase<EpiSwiglu, StaticOrder, true, true>(F.lds + RING_OFF, g, S, E, F.wave); } SEAM(14);
    if (IN(15)) { Gemm g{HID, (const bf16_t*)(F.ws + WS_W2D), M_TOK, DM, FF}; StaticOrder S; S.init(M_TOK, DM, F.G, cid); EpiResid E{F.out, F.out, XB, RS};
        gemm_phase<EpiResid, StaticOrder, false, true>(F.lds + RING_OFF, g, S, E, F.wave); } SEAM(15);
    if (IN(16)) { Gemm g{(const bf16_t*)(F.ws + WS_PB), (const bf16_t*)(F.ws + WS_WPP), M_TOK, DM, 256}; StaticOrder S; S.init(M_TOK, DM, F.G, cid); EpiPlain E{(bf16_t*)(F.ws + WS_PP), DM};
        gemm_phase<EpiPlain, StaticOrder, true, true>(F.lds + RING_OFF, g, S, E, F.wave); } SEAM(16);
    if (IN(17)) { Gemm g{XB, (const bf16_t*)(F.ws + WS_WPG), M_TOK, DM, DM}; StaticOrder S; S.init(M_TOK, DM, F.G, cid); EpiPle E{F.out, (const bf16_t*)(F.ws + WS_PP), RS, RS2};
        gemm_phase<EpiPle, StaticOrder, false, true>(F.lds + RING_OFF, g, S, E, F.wave); } SEAM(17);
    if (IN(18)) { final_norm_phase(F); }
#undef IN
#undef SEAM
}

extern "C" void kernel_launch(void* const* d_in, const int* in_sizes, int n_in, void* d_out, int out_size, void* d_ws, size_t ws_size, hipStream_t stream) {
    static int grid = 0;
    if (grid == 0) {
        if (n_in != 30 || in_sizes[0] != M_TOK * DM || out_size != M_TOK * DM || ws_size < WS_END) { fprintf(stderr, "kernel_launch: unexpected shapes (n_in %d, in0 %d, out %d, ws %zu)\n", n_in, n_in > 0 ? in_sizes[0] : -1, out_size, ws_size); grid = -1; return; }
        int dev = 0, cus = 0, per_cu = 0;
        if (hipGetDevice(&dev) != hipSuccess || hipDeviceGetAttribute(&cus, hipDeviceAttributeMultiprocessorCount, dev) != hipSuccess) { grid = -1; return; }
        if (hipFuncSetAttribute((const void*)blk_fwd, hipFuncAttributeMaxDynamicSharedMemorySize, LDS_BYTES) != hipSuccess) { fprintf(stderr, "kernel_launch: hipFuncSetAttribute failed\n"); grid = -1; return; }
        if (hipOccupancyMaxActiveBlocksPerMultiprocessor(&per_cu, (const void*)blk_fwd, NWAVES * 64, LDS_BYTES) != hipSuccess || per_cu < 1) { fprintf(stderr, "kernel_launch: occupancy query says %d blocks per CU\n", per_cu); per_cu = 1; }
        (void)hipGetLastError();
        grid = cus;
        if (grid != 256) fprintf(stderr, "kernel_launch: %d CUs; the N = 1024 residual phases need a 256-workgroup grid\n", grid);
    }
    if (grid < 0) return;
    (void)hipMemsetAsync((char*)d_ws + WS_CTL, 0, CTL_ZERO_BYTES, stream);
    Args a{};
    for (int i = 0; i < 30; ++i) a.in[i] = (const float*)d_in[i];
    a.out = (float*)d_out; a.ws = (unsigned char*)d_ws;
    if (N_LAUNCHES == 1) {
        a.ph_lo = 0; a.ph_hi = NPHASE;
        void* kargs[] = {&a};
        hipError_t e = hipLaunchCooperativeKernel((const void*)blk_fwd, dim3(grid), dim3(NWAVES * 64), kargs, LDS_BYTES, stream);
        if (e != hipSuccess) { fprintf(stderr, "kernel_launch: cooperative launch failed: %s; plain launch instead\n", hipGetErrorString(e)); (void)hipGetLastError(); hipLaunchKernelGGL(blk_fwd, dim3(grid), dim3(NWAVES * 64), LDS_BYTES, stream, a); }
    } else {
        for (int li = 0; li < NPHASE; ++li) { a.ph_lo = li; a.ph_hi = li + 1; hipLaunchKernelGGL(blk_fwd, dim3(grid), dim3(NWAVES * 64), LDS_BYTES, stream, a); }
    }
}
```

```cpp
#include <hip/hip_runtime.h>
#include <cstdio>
#include <cstdint>
__device__ __forceinline__ int hw_lane() { int l; asm volatile("v_mbcnt_lo_u32_b32 %0, -1, 0\n\tv_mbcnt_hi_u32_b32 %0, -1, %0" : "=v"(l)); return l; }
namespace pg8 {
#define PG8_LAS __attribute__((address_space(3)))
typedef unsigned short bf16_t;
typedef short bf16x8 __attribute__((ext_vector_type(8)));
typedef float f32x4 __attribute__((ext_vector_type(4)));
typedef unsigned u32x4 __attribute__((ext_vector_type(4)));
constexpr int BM = 256, BK = 64, HALF = 128, HTB = HALF * BK * 2  , STAGE_BYTES = 8 * HTB, NXCD = 8, WGM = 8;

__host__ __device__ __forceinline__ int lds_byte(int r, int c) { const int st = (r >> 4) * 2 + (c >> 5), rr = r & 15, cc = c & 31, ob = rr * 64 + cc * 2; return st * 1024 + (ob ^ (((ob >> 9) & 1) << 5)); }
__host__ __device__ __forceinline__ void stage_rc(int b, int& R, int& C) { const int st = b / 1024, sb = b % 1024, swz = sb ^ (((sb >> 9) & 1) << 5); R = (st >> 1) * 16 + swz / 64; C = (st & 1) * 32 + (swz % 64) / 2; }
__host__ __device__ __forceinline__ int perm32(int rho) { const int n = rho >> 4, i = rho & 15; return 8 * (i >> 2) + 4 * n + (i & 3); }

struct Unit { int pm, pn; };
struct Gemm { const bf16_t* A; const bf16_t* Bt; int M, N, K; };

struct StaticOrder {
    int nM, nN, nwg, G, c;
    __host__ __device__ void init(int M, int N, int G_, int c_) { nM = M / BM; nN = N / BM; nwg = nM * nN; G = G_; c = c_; }
    __host__ __device__ bool next(int i, Unit& u) const {
        const long L = (long)i * G + c; if (L >= nwg) return false;
        int wgid = (int)L; { const int q = nwg / NXCD, r = nwg % NXCD, xcd = wgid % NXCD, off = wgid / NXCD; wgid = (xcd < r ? xcd * (q + 1) : r * (q + 1) + (xcd - r) * q) + off; }
        const int nig = WGM * nN, gid = wgid / nig, fm = gid * WGM, gsz = (nM - fm) < WGM ? (nM - fm) : WGM;
        u.pm = fm + ((wgid % nig) % gsz); u.pn = (wgid % nig) / gsz; return true;
    }
    __device__ __forceinline__ void a_ready(const Unit&) const {}
    __device__ __forceinline__ void done(const Unit&) const {}
};

__device__ __forceinline__ unsigned cvt_pk_bf16(float lo, float hi) { unsigned r; asm volatile("v_cvt_pk_bf16_f32 %0, %1, %2" : "=v"(r) : "v"(lo), "v"(hi)); return r; }
typedef float f32x2 __attribute__((ext_vector_type(2)));
template <class Epi, class Sched, bool ALIGN_EPI = false, bool SP2 = false>
__device__ __forceinline__ void gemm_phase(PG8_LAS unsigned char* lds, const Gemm g, const Sched& S, const Epi& E, const int wid) {
    const int lane = hw_lane(), tid = wid * 64 + lane, wr = wid >> 2, wc = wid & 3, fr = lane & 15, fq = lane >> 4;
    const int K = g.K, nt = K / BK;
    unsigned voffA[2], voffB[2];
#pragma unroll
    for (int i = 0; i < 2; ++i) { int R, C; stage_rc(tid * 16 + i * 8192, R, C); const int Rb = Epi::PERM ? ((R & ~31) + perm32(R & 31)) : R;
        voffA[i] = (unsigned)(R * K + C) * 2u; voffB[i] = (unsigned)(Rb * K + C) * 2u; }
    const size_t kstep = (size_t)(BK * 2);
    const size_t hstep = (size_t)HALF * K * 2;
    const size_t tstep = 2 * hstep;
    const unsigned ldsw = (unsigned)wid * 1024u;
    const int aoff = lds_byte(wr * 64 + fr, fq * 8), boff = lds_byte(wc * 32 + fr, fq * 8);
#define PG8_SA(b, h) (((b) * 2 + (h)) * HTB)
#define PG8_SB(b, h) ((4 + (b) * 2 + (h)) * HTB)
#define PG8_STAGE(bufoff, gbase, voff) do { _Pragma("unroll") for (int _i = 0; _i < 2; ++_i) \
        __builtin_amdgcn_global_load_lds((const unsigned*)((const char*)(gbase) + (voff)[_i]), (PG8_LAS unsigned*)(lds + (bufoff) + ldsw + _i * 8192), 16, 0, 0); } while (0)
#define PG8_LDA(dst, b, h) do { _Pragma("unroll") for (int m = 0; m < 4; ++m) _Pragma("unroll") for (int k = 0; k < 2; ++k) dst[m][k] = *(const PG8_LAS bf16x8*)(lds + PG8_SA(b, h) + aoff + m * 2048 + k * 1024); } while (0)
#define PG8_LDB(dst, b, h) do { _Pragma("unroll") for (int n = 0; n < 2; ++n) _Pragma("unroll") for (int k = 0; k < 2; ++k) dst[n][k] = *(const PG8_LAS bf16x8*)(lds + PG8_SB(b, h) + boff + n * 2048 + k * 1024); } while (0)
#define PG8_MMA(ai, bj, At, Bt) do { __builtin_amdgcn_s_setprio(1); _Pragma("unroll") for (int m = 0; m < 4; ++m) _Pragma("unroll") for (int n = 0; n < 2; ++n) _Pragma("unroll") for (int k = 0; k < 2; ++k) \
        acc[ai][bj][m][n] = __builtin_amdgcn_mfma_f32_16x16x32_bf16(Bt[n][k], At[m][k], acc[ai][bj][m][n], 0, 0, 0); __builtin_amdgcn_s_setprio(0); } while (0)
#define PG8_WAIT_V(n) asm volatile("s_waitcnt vmcnt(" #n ")" ::: "memory")
#define PG8_WAIT_L(n) asm volatile("s_waitcnt lgkmcnt(" #n ")" ::: "memory")
#define PG8_BAR __builtin_amdgcn_s_barrier()
#define PG8_SCHED __builtin_amdgcn_sched_barrier(0)
    Unit cur, nxt; int ui = 0;
    if (!S.next(0, cur)) return;
    f32x4 acc[2][2][4][2];
#pragma unroll
    for (int a = 0; a < 2; ++a)
#pragma unroll
        for (int b = 0; b < 2; ++b)
#pragma unroll
            for (int m = 0; m < 4; ++m)
#pragma unroll
                for (int n = 0; n < 2; ++n) acc[a][b][m][n] = (f32x4){0.f, 0.f, 0.f, 0.f};
    bf16x8 At[4][2], B0[2][2], B1[2][2];
    const char* cA = (const char*)g.A + (size_t)cur.pm * tstep; const char* cB = (const char*)g.Bt + (size_t)cur.pn * tstep;
    S.a_ready(cur);
    if constexpr (SP2) {
        PG8_STAGE(PG8_SB(0, 0), cB, voffB); PG8_STAGE(PG8_SB(0, 1), cB + hstep, voffB); PG8_STAGE(PG8_SA(0, 0), cA, voffA); PG8_STAGE(PG8_SA(0, 1), cA + hstep, voffA);
        if (wr == 1) PG8_BAR;
        PG8_WAIT_V(2); PG8_BAR;
        PG8_STAGE(PG8_SB(1, 0), cB + kstep, voffB); PG8_STAGE(PG8_SA(1, 0), cA + kstep, voffA); PG8_STAGE(PG8_SB(1, 1), cB + hstep + kstep, voffB);
        PG8_WAIT_V(6); PG8_BAR;
    } else {
        PG8_STAGE(PG8_SB(0, 0), cB, voffB); PG8_STAGE(PG8_SA(0, 0), cA, voffA); PG8_STAGE(PG8_SB(0, 1), cB + hstep, voffB); PG8_STAGE(PG8_SA(0, 1), cA + hstep, voffA);
        if (wr == 1) PG8_BAR;
        PG8_WAIT_V(4); PG8_BAR;
        PG8_STAGE(PG8_SB(1, 0), cB + kstep, voffB); PG8_STAGE(PG8_SA(1, 0), cA + kstep, voffA); PG8_STAGE(PG8_SB(1, 1), cB + hstep + kstep, voffB);
        PG8_WAIT_V(6); PG8_BAR;
    }
    for (;;) {
        const bool has_next = S.next(ui + 1, nxt);
        const char* nA = has_next ? (const char*)g.A + (size_t)nxt.pm * tstep : cA; const char* nB = has_next ? (const char*)g.Bt + (size_t)nxt.pn * tstep : cB;
        for (int t = 0; t < nt; t += 2) {
            const bool last = (t == nt - 2);
            const char* a1 = cA + (size_t)(t + 1) * kstep;
            const char* a2 = last ? nA : cA + (size_t)(t + 2) * kstep; const char* b2 = last ? nB : cB + (size_t)(t + 2) * kstep;
            const char* a3 = a2 + kstep; const char* b3 = b2 + kstep;
            if (last && has_next) S.a_ready(nxt);
            if constexpr (SP2) {
            PG8_LDB(B0, 0, 0); PG8_LDB(B1, 0, 1); PG8_SCHED; PG8_LDA(At, 0, 0); PG8_STAGE(PG8_SA(1, 1), a1 + hstep, voffA);
            PG8_WAIT_V(8); PG8_WAIT_L(0); PG8_BAR; PG8_MMA(0, 0, At, B0); PG8_MMA(0, 1, At, B1); PG8_BAR; PG8_SCHED;
            PG8_LDA(At, 0, 1); PG8_STAGE(PG8_SB(0, 0), b2, voffB); PG8_STAGE(PG8_SB(0, 1), b2 + hstep, voffB); PG8_STAGE(PG8_SA(0, 0), a2, voffA);
            PG8_WAIT_V(8); PG8_WAIT_L(0); PG8_BAR; PG8_MMA(1, 0, At, B0); PG8_MMA(1, 1, At, B1); PG8_BAR; PG8_SCHED;
            PG8_LDB(B0, 1, 0); PG8_LDB(B1, 1, 1); PG8_SCHED; PG8_LDA(At, 1, 0); PG8_STAGE(PG8_SA(0, 1), a2 + hstep, voffA);
            PG8_WAIT_V(8); PG8_WAIT_L(0); PG8_BAR; PG8_MMA(0, 0, At, B0); PG8_MMA(0, 1, At, B1); PG8_BAR; PG8_SCHED;
            PG8_LDA(At, 1, 1); PG8_STAGE(PG8_SB(1, 0), b3, voffB); PG8_STAGE(PG8_SB(1, 1), b3 + hstep, voffB); PG8_STAGE(PG8_SA(1, 0), a3, voffA);
            PG8_WAIT_V(8); PG8_WAIT_L(0); PG8_BAR; PG8_MMA(1, 0, At, B0); PG8_MMA(1, 1, At, B1); PG8_BAR; PG8_SCHED;
            } else {
            PG8_LDB(B0, 0, 0); PG8_SCHED; PG8_LDA(At, 0, 0); PG8_STAGE(PG8_SA(1, 1), a1 + hstep, voffA);
            PG8_WAIT_L(8); PG8_BAR; PG8_WAIT_L(0); PG8_MMA(0, 0, At, B0); PG8_BAR; PG8_SCHED;
            PG8_LDB(B1, 0, 1); PG8_STAGE(PG8_SB(0, 0), b2, voffB);
            PG8_BAR; PG8_WAIT_L(0); PG8_MMA(0, 1, At, B1); PG8_BAR;
            PG8_LDA(At, 0, 1); PG8_STAGE(PG8_SA(0, 0), a2, voffA);
            PG8_BAR; PG8_WAIT_L(0); PG8_MMA(1, 0, At, B0); PG8_BAR; PG8_SCHED;
            PG8_STAGE(PG8_SB(0, 1), b2 + hstep, voffB);
            PG8_WAIT_V(6); PG8_BAR; PG8_MMA(1, 1, At, B1); PG8_BAR;
            PG8_LDB(B0, 1, 0); PG8_SCHED; PG8_LDA(At, 1, 0); PG8_STAGE(PG8_SA(0, 1), a2 + hstep, voffA);
            PG8_WAIT_L(8); PG8_BAR; PG8_WAIT_L(0); PG8_MMA(0, 0, At, B0); PG8_BAR; PG8_SCHED;
            PG8_LDB(B1, 1, 1); PG8_STAGE(PG8_SB(1, 0), b3, voffB);
            PG8_BAR; PG8_WAIT_L(0); PG8_MMA(0, 1, At, B1); PG8_BAR;
            PG8_LDA(At, 1, 1); PG8_STAGE(PG8_SA(1, 0), a3, voffA);
            PG8_BAR; PG8_WAIT_L(0); PG8_MMA(1, 0, At, B0); PG8_BAR; PG8_SCHED;
            PG8_STAGE(PG8_SB(1, 1), b3 + hstep, voffB);
            PG8_WAIT_V(6); PG8_BAR; PG8_MMA(1, 1, At, B1); PG8_BAR;
            }
        }
        if constexpr (ALIGN_EPI) { if (wr == 0) PG8_BAR; }
        if constexpr (!Epi::AFTER_DRAIN) { E(acc, cur, wr, wc, fr, fq); S.done(cur); }
        if (!has_next) break;
#pragma unroll
        for (int a = 0; a < 2; ++a)
#pragma unroll
            for (int b = 0; b < 2; ++b)
#pragma unroll
                for (int m = 0; m < 4; ++m)
#pragma unroll
                    for (int n = 0; n < 2; ++n) acc[a][b][m][n] = (f32x4){0.f, 0.f, 0.f, 0.f};
        cur = nxt; cA = nA; cB = nB; ++ui;
        if constexpr (ALIGN_EPI) { if (wr == 1) PG8_BAR; }
    }
    PG8_WAIT_V(0);
    if constexpr (!ALIGN_EPI) { if (wr == 0) PG8_BAR; }
    PG8_BAR;
    if constexpr (Epi::AFTER_DRAIN) { E.fused(acc, cur, wr, wc, fr, fq, lds, wid, lane); S.done(cur); }
#undef PG8_SA
#undef PG8_SB
#undef PG8_STAGE
#undef PG8_LDA
#undef PG8_LDB
#undef PG8_MMA
#undef PG8_WAIT_V
#undef PG8_WAIT_L
#undef PG8_BAR
#undef PG8_SCHED
}

constexpr int M_TOK = 16384, DM = 1024, FF = 2816, NIN = 6656, SEQ = 4096, NBATCH = 4;
constexpr int S5T = 32, S5NC = SEQ / S5T  , S5ROWS = NBATCH * S5NC  ;

struct BatchOrder {
    int nMg, nNg, per, total, G, c;
    __host__ __device__ void init(int ng, int nMg_, int nNg_, int G_, int c_) { nMg = nMg_; nNg = nNg_; per = nMg_ * nNg_; total = ng * per; G = G_; c = c_; }
    __host__ __device__ bool next(int i, Unit& u) const { const int L = i * G + c; if (L >= total) return false; const int g = L / per, r = L % per; u.pm = g * nMg + (r % nMg); u.pn = g * nNg + (r / nMg); return true; }
    __device__ __forceinline__ void a_ready(const Unit&) const {}
    __device__ __forceinline__ void done(const Unit&) const {}
};

typedef unsigned u32x2 __attribute__((ext_vector_type(2)));
__device__ __forceinline__ float sigm(float z) { return __builtin_amdgcn_rcpf(1.f + __builtin_amdgcn_exp2f(-1.44269504f * z)); }
__device__ __forceinline__ float bf_lo(unsigned w) { return __builtin_bit_cast(float, w << 16); }
__device__ __forceinline__ float bf_hi(unsigned w) { return __builtin_bit_cast(float, w & 0xffff0000u); }
__device__ __forceinline__ u32x4 pack8(const float (&v)[8]) { u32x4 w; w.x = cvt_pk_bf16(v[0], v[1]); w.y = cvt_pk_bf16(v[2], v[3]); w.z = cvt_pk_bf16(v[4], v[5]); w.w = cvt_pk_bf16(v[6], v[7]); return w; }
__device__ __forceinline__ void unpack8(const u32x4 w, float (&v)[8]) { v[0] = bf_lo(w.x); v[1] = bf_hi(w.x); v[2] = bf_lo(w.y); v[3] = bf_hi(w.y); v[4] = bf_lo(w.z); v[5] = bf_hi(w.z); v[6] = bf_lo(w.w); v[7] = bf_hi(w.w); }
__device__ __forceinline__ void row_scales(const float* RS, int row0, float (&r)[2][4]) {
#pragma unroll
    for (int ai = 0; ai < 2; ++ai)
#pragma unroll
        for (int m = 0; m < 4; ++m) { const f32x4 p = *(const f32x4*)(RS + (size_t)(row0 + ai * HALF + m * 16) * 4); r[ai][m] = __builtin_amdgcn_rsqf(((p.x + p.y) + (p.z + p.w)) * (1.0f / 1024.0f) + 1e-6f); }
}

struct EpiSwiglu {
    static constexpr bool PERM = true, AFTER_DRAIN = false;
    bf16_t* HID; const float* RS;
    __device__ __forceinline__ void operator()(const f32x4 (&acc)[2][2][4][2], const Unit& u, int wr, int wc, int fr, int fq) const {
        const int row0 = u.pm * BM + wr * 64 + fr, ch0 = u.pn * HALF + wc * 32 + 8 * fq;
        float r[2][4]; row_scales(RS, row0, r);
#pragma unroll
        for (int ai = 0; ai < 2; ++ai)
#pragma unroll
            for (int m = 0; m < 4; ++m) { const float rr = r[ai][m]; float h[8];
#pragma unroll
                for (int n = 0; n < 2; ++n)
#pragma unroll
                    for (int e = 0; e < 4; ++e) { const float g = acc[ai][0][m][n][e] * rr, up = acc[ai][1][m][n][e] * rr; h[4 * n + e] = g * sigm(g) * up; }
                *(u32x4*)(HID + (size_t)(row0 + ai * HALF + m * 16) * FF + ch0) = pack8(h); }
    }
};

struct EpiResid {
    static constexpr bool PERM = false, AFTER_DRAIN = true;
    const float* resf; bf16_t* XB; float* RSout;
    __device__ __forceinline__ void fused(f32x4 (&acc)[2][2][4][2], const Unit& u, int wr, int wc, int fr, int fq, PG8_LAS unsigned char* lds, int wid, int lane) const {
        PG8_LAS float* PS = (PG8_LAS float*)lds;
        const int col0 = u.pn * BM + wc * 32 + 4 * fq;
#pragma unroll
        for (int ai = 0; ai < 2; ++ai)
#pragma unroll
            for (int m = 0; m < 4; ++m) { const int rl = ai * HALF + wr * 64 + m * 16 + fr; const size_t off = (size_t)(u.pm * BM + rl) * DM + col0; float s = 0.f;
#pragma unroll
                for (int bj = 0; bj < 2; ++bj)
#pragma unroll
                    for (int n = 0; n < 2; ++n) { f32x4 b;
                        if (resf) b = *(const f32x4*)(resf + off + bj * HALF + n * 16);
                        else { const u32x2 rw = *(const u32x2*)(XB + off + bj * HALF + n * 16); b = (f32x4){bf_lo(rw.x), bf_hi(rw.x), bf_lo(rw.y), bf_hi(rw.y)}; }
                        const f32x4 v = b + acc[ai][bj][m][n];
                        u32x2 w; w.x = cvt_pk_bf16(v[0], v[1]); w.y = cvt_pk_bf16(v[2], v[3]); *(u32x2*)(XB + off + bj * HALF + n * 16) = w;
                        s += (v[0] * v[0] + v[1] * v[1]) + (v[2] * v[2] + v[3] * v[3]); }
                s += __shfl_xor(s, 16); s += __shfl_xor(s, 32);
                if (fq == 0) PS[rl * 4 + wc] = s; }
        asm volatile("s_waitcnt lgkmcnt(0)" ::: "memory"); __builtin_amdgcn_s_barrier(); asm volatile("" ::: "memory");
        const int tid = wid * 64 + lane;
        if (tid < 256) { const f32x4 p = *(const PG8_LAS f32x4*)(PS + tid * 4); RSout[(size_t)(u.pm * BM + tid) * 4 + u.pn] = (p.x + p.y) + (p.z + p.w); }
    }
};

struct EpiPle {
    static constexpr bool PERM = false, AFTER_DRAIN = true;
    float* H; const bf16_t* XB; const bf16_t* PP; const float* RS; float* RSout;
    __device__ __forceinline__ void fused(f32x4 (&acc)[2][2][4][2], const Unit& u, int wr, int wc, int fr, int fq, PG8_LAS unsigned char* lds, int wid, int lane) const {
        PG8_LAS float* PS = (PG8_LAS float*)lds;
        const int col0 = u.pn * BM + wc * 32 + 4 * fq;
        float r[2][4]; row_scales(RS, u.pm * BM + wr * 64 + fr, r);
#pragma unroll
        for (int ai = 0; ai < 2; ++ai)
#pragma unroll
            for (int m = 0; m < 4; ++m) { const int rl = ai * HALF + wr * 64 + m * 16 + fr; const size_t off = (size_t)(u.pm * BM + rl) * DM + col0; float s = 0.f; const float rr = r[ai][m];
#pragma unroll
                for (int bj = 0; bj < 2; ++bj)
#pragma unroll
                    for (int n = 0; n < 2; ++n) { const u32x2 rw = *(const u32x2*)(XB + off + bj * HALF + n * 16); const f32x4 b = (f32x4){bf_lo(rw.x), bf_hi(rw.x), bf_lo(rw.y), bf_hi(rw.y)}; const u32x2 pw = *(const u32x2*)(PP + off + bj * HALF + n * 16); const f32x4 a = acc[ai][bj][m][n];
                        f32x4 v; v[0] = b[0] + sigm(a[0] * rr) * bf_lo(pw.x); v[1] = b[1] + sigm(a[1] * rr) * bf_hi(pw.x); v[2] = b[2] + sigm(a[2] * rr) * bf_lo(pw.y); v[3] = b[3] + sigm(a[3] * rr) * bf_hi(pw.y);
                        *(f32x4*)(H + off + bj * HALF + n * 16) = v; s += (v[0] * v[0] + v[1] * v[1]) + (v[2] * v[2] + v[3] * v[3]); }
                s += __shfl_xor(s, 16); s += __shfl_xor(s, 32);
                if (fq == 0) PS[rl * 4 + wc] = s; }
        asm volatile("s_waitcnt lgkmcnt(0)" ::: "memory"); __builtin_amdgcn_s_barrier(); asm volatile("" ::: "memory");
        const int tid = wid * 64 + lane;
        if (tid < 256) { const f32x4 p = *(const PG8_LAS f32x4*)(PS + tid * 4); RSout[(size_t)(u.pm * BM + tid) * 4 + u.pn] = (p.x + p.y) + (p.z + p.w); }
    }
};

struct EpiProj {
    static constexpr bool PERM = true, AFTER_DRAIN = false;
    int pn_off; const float* RS; bf16_t* S5IN; bf16_t* Q; unsigned short* G16; bf16_t* I; bf16_t* O; const float* RINV; const float* hg_gain; bf16_t* GA; bf16_t* GB; const float* LB;
    __device__ __forceinline__ void operator()(const f32x4 (&acc)[2][2][4][2], const Unit& u, int wr, int wc, int fr, int fq) const {
        const int pnabs = u.pn + pn_off, row0 = u.pm * BM + wr * 64 + fr;
        const int kind = pnabs < 2 ? 0 : ((pnabs - 2) >> 2) + 1;
        const int cb = (kind == 0 ? pnabs * BM : ((pnabs - 2) & 3) * BM) + wc * 32 + 8 * fq;
        float r[2][4]; row_scales(RS, row0, r);
#pragma unroll
        for (int ai = 0; ai < 2; ++ai)
#pragma unroll
            for (int m = 0; m < 4; ++m) { const float rr = r[ai][m]; const int row = row0 + ai * HALF + m * 16;
#pragma unroll
                for (int bj = 0; bj < 2; ++bj) { const int c = cb + bj * HALF; float v[8];
#pragma unroll
                    for (int n = 0; n < 2; ++n)
#pragma unroll
                        for (int e = 0; e < 4; ++e) v[4 * n + e] = acc[ai][bj][m][n][e] * rr;
                    if (kind == 0) { *(u32x4*)(S5IN + ((size_t)(c >> 4) * M_TOK + row) * 16 + (c & 15)) = pack8(v); }
                    else if (kind == 1) {
#pragma unroll
                        for (int e = 0; e < 8; ++e) v[e] *= 0.08838834764831845f;
                        *(u32x4*)(Q + (size_t)row * DM + c) = pack8(v); }
                    else if (kind == 2) { const f32x4 l0 = *(const f32x4*)(LB + c), l1 = *(const f32x4*)(LB + c + 4); _Float16 h[8];
#pragma unroll
                        for (int e = 0; e < 8; ++e) { const float lb = e < 4 ? l0[e] : l1[e - 4]; h[e] = (_Float16)__logf(lb + (1.f - lb) * sigm(v[e])); }
                        u32x4 w; w.x = (unsigned)__builtin_bit_cast(unsigned short, h[0]) | ((unsigned)__builtin_bit_cast(unsigned short, h[1]) << 16); w.y = (unsigned)__builtin_bit_cast(unsigned short, h[2]) | ((unsigned)__builtin_bit_cast(unsigned short, h[3]) << 16);
                        w.z = (unsigned)__builtin_bit_cast(unsigned short, h[4]) | ((unsigned)__builtin_bit_cast(unsigned short, h[5]) << 16); w.w = (unsigned)__builtin_bit_cast(unsigned short, h[6]) | ((unsigned)__builtin_bit_cast(unsigned short, h[7]) << 16);
                        *(u32x4*)(G16 + (size_t)row * DM + c) = w; }
                    else if (kind == 3) { *(u32x4*)(I + (size_t)row * DM + c) = pack8(v); }
                    else if (kind == 4) { float o[8]; unpack8(*(const u32x4*)(O + (size_t)row * DM + c), o); const float* rp = RINV + ((size_t)row * 8 + (c >> 7)) * 8; const f32x4 p0 = *(const f32x4*)rp, p1 = *(const f32x4*)(rp + 4); const float ri = __builtin_amdgcn_rsqf((((p0.x + p0.y) + (p0.z + p0.w)) + ((p1.x + p1.y) + (p1.z + p1.w))) * (1.0f / 128.0f) + 1e-6f); const f32x4 g0 = *(const f32x4*)(hg_gain + c), g1 = *(const f32x4*)(hg_gain + c + 4);
#pragma unroll
                        for (int e = 0; e < 8; ++e) o[e] = o[e] * ri * (e < 4 ? g0[e] : g1[e - 4]) * (v[e] * sigm(v[e]));
                        *(u32x4*)(O + (size_t)row * DM + c) = pack8(o); }
                    else {
#pragma unroll
                        for (int e = 0; e < 8; ++e) v[e] = sigm(v[e]);
                        *(u32x4*)((kind == 5 ? GA : GB) + (size_t)row * DM + c) = pack8(v); }
                } }
    }
};

struct EpiGlu {
    static constexpr bool PERM = true, AFTER_DRAIN = false;
    bf16_t* MIX;
    __device__ __forceinline__ void operator()(const f32x4 (&acc)[2][2][4][2], const Unit& u, int wr, int wc, int fr, int fq) const {
        const int row0 = u.pm * BM + wr * 64 + fr, ch0 = u.pn * HALF + wc * 32 + 8 * fq;
#pragma unroll
        for (int ai = 0; ai < 2; ++ai)
#pragma unroll
            for (int m = 0; m < 4; ++m) { bf16_t* p = MIX + (size_t)(row0 + ai * HALF + m * 16) * DM + ch0; float ga[8], h[8]; unpack8(*(const u32x4*)p, ga);
#pragma unroll
                for (int n = 0; n < 2; ++n)
#pragma unroll
                    for (int e = 0; e < 4; ++e) h[4 * n + e] = ga[4 * n + e] * acc[ai][0][m][n][e] * sigm(acc[ai][1][m][n][e]);
                *(u32x4*)p = pack8(h); }
    }
};
struct EpiHgOut {
    static constexpr bool PERM = true, AFTER_DRAIN = false;
    bf16_t* MIX; const bf16_t* GB;
    __device__ __forceinline__ void operator()(const f32x4 (&acc)[2][2][4][2], const Unit& u, int wr, int wc, int fr, int fq) const {
        const int row0 = u.pm * BM + wr * 64 + fr, c0 = u.pn * BM + wc * 32 + 8 * fq;
#pragma unroll
        for (int ai = 0; ai < 2; ++ai)
#pragma unroll
            for (int m = 0; m < 4; ++m)
#pragma unroll
                for (int bj = 0; bj < 2; ++bj) { const size_t off = (size_t)(row0 + ai * HALF + m * 16) * DM + c0 + bj * HALF; float a[8], b[8]; unpack8(*(const u32x4*)(MIX + off), a); unpack8(*(const u32x4*)(GB + off), b);
#pragma unroll
                    for (int n = 0; n < 2; ++n)
#pragma unroll
                        for (int e = 0; e < 4; ++e) a[4 * n + e] += b[4 * n + e] * acc[ai][bj][m][n][e];
                    *(u32x4*)(MIX + off) = pack8(a); }
    }
};
struct EpiPlain {
    static constexpr bool PERM = true, AFTER_DRAIN = false;
    bf16_t* O; int ldc;
    __device__ __forceinline__ void operator()(const f32x4 (&acc)[2][2][4][2], const Unit& u, int wr, int wc, int fr, int fq) const {
        const int row0 = u.pm * BM + wr * 64 + fr, c0 = u.pn * BM + wc * 32 + 8 * fq;
#pragma unroll
        for (int ai = 0; ai < 2; ++ai)
#pragma unroll
            for (int m = 0; m < 4; ++m)
#pragma unroll
                for (int bj = 0; bj < 2; ++bj) { float v[8];
#pragma unroll
                    for (int n = 0; n < 2; ++n)
#pragma unroll
                        for (int e = 0; e < 4; ++e) v[4 * n + e] = acc[ai][bj][m][n][e];
                    *(u32x4*)(O + (size_t)(row0 + ai * HALF + m * 16) * ldc + c0 + bj * HALF) = pack8(v); }
    }
};
struct EpiS5a {
    static constexpr bool PERM = true, AFTER_DRAIN = false;
    bf16_t* YS5; float* XL;
    __device__ __forceinline__ void operator()(const f32x4 (&acc)[2][2][4][2], const Unit& u, int wr, int wc, int fr, int fq) const {
        const int g = u.pm >> 1, pml = u.pm & 1, pnl = u.pn - 3 * g;
#pragma unroll
        for (int ai = 0; ai < 2; ++ai)
#pragma unroll
            for (int m = 0; m < 4; ++m) { const int R = pml * BM + ai * HALF + wr * 64 + m * 16 + fr;
#pragma unroll
                for (int bj = 0; bj < 2; ++bj) { float v[8];
#pragma unroll
                    for (int n = 0; n < 2; ++n)
#pragma unroll
                        for (int e = 0; e < 4; ++e) v[4 * n + e] = acc[ai][bj][m][n][e];
                    const int cl = bj * HALF + wc * 32 + 8 * fq;
                    if (pnl < 2) { const int ci = pnl * BM + cl, t = ci >> 4, ho = ci & 15; *(u32x4*)(YS5 + ((size_t)R * S5T + t) * 512 + g * 16 + ho) = pack8(v); }
                    else if (bj == 0) { float* p = XL + ((size_t)(g * S5ROWS + R)) * 128 + cl; *(f32x4*)p = (f32x4){v[0], v[1], v[2], v[3]}; *(f32x4*)(p + 4) = (f32x4){v[4], v[5], v[6], v[7]}; }
                } }
    }
};
struct EpiS5b {
    static constexpr bool PERM = true, AFTER_DRAIN = false;
    bf16_t* YS5;
    __device__ __forceinline__ void operator()(const f32x4 (&acc)[2][2][4][2], const Unit& u, int wr, int wc, int fr, int fq) const {
        const int g = u.pm >> 1, pml = u.pm & 1, pnl = u.pn & 1;
#pragma unroll
        for (int ai = 0; ai < 2; ++ai)
#pragma unroll
            for (int m = 0; m < 4; ++m) { const int R = pml * BM + ai * HALF + wr * 64 + m * 16 + fr;
#pragma unroll
                for (int bj = 0; bj < 2; ++bj) { const int ci = pnl * BM + bj * HALF + wc * 32 + 8 * fq, t = ci >> 4, ho = ci & 15; bf16_t* p = YS5 + ((size_t)R * S5T + t) * 512 + g * 16 + ho; float y[8]; unpack8(*(const u32x4*)p, y);
#pragma unroll
                    for (int n = 0; n < 2; ++n)
#pragma unroll
                        for (int e = 0; e < 4; ++e) { const float x = y[4 * n + e] + acc[ai][bj][m][n][e]; y[4 * n + e] = x * sigm(1.5957691216f * (x + 0.044715f * x * x * x)); }
                    *(u32x4*)p = pack8(y); } }
    }
};
}

constexpr int NWAVES = 8;
#ifndef MK_N_LAUNCHES
#define MK_N_LAUNCHES 1
#endif
constexpr int NPHASE = 19;
constexpr int N_LAUNCHES = MK_N_LAUNCHES;
using pg8::M_TOK; using pg8::DM; using pg8::FF; using pg8::NIN; using pg8::SEQ; using pg8::NBATCH; using pg8::S5T; using pg8::S5NC; using pg8::S5ROWS;
constexpr float NORM_EPS = 1e-6f;

constexpr size_t MiB = 1u << 20, KiB = 1u << 10;
constexpr size_t WS_CTL = 0, CTL_ZERO_BYTES = 1 * MiB;
constexpr size_t WS_W1GU = 1 * MiB, WS_W1D = 12 * MiB, WS_WIN = WS_W1D + 5632 * KiB, WS_WGLU = WS_WIN + 13 * MiB, WS_WHG = WS_WGLU + 2 * MiB, WS_WM = WS_WHG + 2 * MiB,
                 WS_W2GU = WS_WM + 2 * MiB, WS_W2D = WS_W2GU + 11 * MiB, WS_WPG = WS_W2D + 5632 * KiB, WS_WPP = WS_WPG + 2 * MiB;
static_assert(WS_WPP + 512 * KiB <= 56 * MiB, "weights");
constexpr size_t WS_TOEP = 56 * MiB;
constexpr size_t WS_CT = 80 * MiB;
constexpr size_t WS_RS = 88 * MiB, WS_RS2 = WS_RS + 256 * KiB, WS_RINV = WS_RS + 512 * KiB, WS_LB = 89 * MiB, WS_LAMT = WS_LB + 4 * KiB;
constexpr size_t WS_XB = 90 * MiB;
constexpr size_t WS_R = 122 * MiB;
constexpr size_t WS_HID = WS_R;
constexpr size_t WS_YS5 = WS_R, WS_S5IN = WS_R + 16 * MiB, WS_XL = WS_R + 32 * MiB, WS_XP = WS_R + 40 * MiB;
constexpr size_t WS_Q = WS_R + 16 * MiB, WS_G16 = WS_R + 48 * MiB, WS_I = WS_R + 80 * MiB;
constexpr size_t WS_PB = WS_R + 112 * MiB;
constexpr size_t WS_PP = WS_R;
constexpr size_t WS_DF = WS_PB + 8 * MiB;
constexpr size_t WS_RPART = WS_DF + 1 * MiB;
constexpr size_t WS_END = WS_RPART + 4 * MiB;
static_assert(WS_END <= 256 * MiB, "d_ws map");
constexpr int CW_BAR = 4096;

constexpr int RING_OFF = 0, RING_BYTES = 131072;
constexpr int LDS_BYTES = 163840;
constexpr int LDSCTL_OFF = LDS_BYTES - 1024, MISC_OFF = LDSCTL_OFF + 320;

#define GAS __attribute__((address_space(1)))
#define LAS __attribute__((address_space(3)))
typedef unsigned short bf16;
typedef unsigned v4u __attribute__((ext_vector_type(4)));
typedef unsigned v2u __attribute__((ext_vector_type(2)));
typedef float f32x4 __attribute__((ext_vector_type(4)));
typedef float f32x2 __attribute__((ext_vector_type(2)));
typedef short bf16x8 __attribute__((ext_vector_type(8)));
typedef short s16x4 __attribute__((ext_vector_type(4)));
typedef GAS unsigned gu32;
#define RLX_AGENT __ATOMIC_RELAXED, __HIP_MEMORY_SCOPE_AGENT
#define LDS_WAIT() asm volatile("s_waitcnt lgkmcnt(0)" ::: "memory")
#define VM_WAIT() asm volatile("s_waitcnt vmcnt(0)" ::: "memory")
__device__ __forceinline__ unsigned f2bf(float f) { unsigned u = __builtin_bit_cast(unsigned, f); return (u + 0x7fffu + ((u >> 16) & 1u)) >> 16; }
__device__ __forceinline__ unsigned pk2(float lo, float hi) { return f2bf(lo) | (f2bf(hi) << 16); }
__device__ __forceinline__ float bflo(unsigned w) { return __builtin_bit_cast(float, w << 16); }
__device__ __forceinline__ float bfhi(unsigned w) { return __builtin_bit_cast(float, w & 0xffff0000u); }
#define XB_TMO      128
#define XB_XCNT(j)  (256  + 64 * (j))
#define XB_XSUB(j)  (1280 + 64 * (j))
#define XB_XGEN(j)  (2304 + 64 * (j))
#define XB_TOP      3328
#define XB_TOPGEN   3392
#define XCD_BAR_WORDS 3456
#define XB_SPIN_CAP (1u << 18)

__device__ __forceinline__ unsigned xb_ld(unsigned* p)              { return __hip_atomic_load(p, __ATOMIC_RELAXED, __HIP_MEMORY_SCOPE_AGENT); }
__device__ __forceinline__ unsigned xb_add(unsigned* p, unsigned v) { return __hip_atomic_fetch_add(p, v, __ATOMIC_RELAXED, __HIP_MEMORY_SCOPE_AGENT); }
__device__ __forceinline__ unsigned xb_xcc_id() { return (unsigned)__builtin_amdgcn_s_getreg((3 << 11) | 20) & 0xFu; }
#define XB_SPIN(cond, bar) do { unsigned _sp = 0; while (cond) { __builtin_amdgcn_s_sleep(1); \
    if ((++_sp & 255u) == 0u) { if (xb_ld(&(bar)[XB_TMO])) break; if (_sp > XB_SPIN_CAP) { atomicAdd(&(bar)[XB_TMO], 1u); break; } } } } while (0)

struct XcdBarrier {
    unsigned* bar; unsigned x; int wave;
    volatile LAS unsigned* st;
};

__device__ __forceinline__ XcdBarrier xcd_barrier_post(unsigned* bar, volatile LAS unsigned* st) {
    XcdBarrier b; b.bar = bar; b.x = xb_xcc_id(); b.st = st;
    if (threadIdx.x == 0) (void)xb_add(&bar[XB_XCNT(b.x)], 1u);
    return b;
}
__device__ __forceinline__ void xcd_barrier_complete(unsigned* bar, unsigned x, unsigned& nloc, unsigned& nx) {
    const unsigned G = gridDim.x * gridDim.y * gridDim.z;
    unsigned sum, cnt, mine, sp = 0u;
    for (;;) {
        sum = 0u; cnt = 0u; mine = 0u;
#pragma unroll
        for (unsigned j = 0; j < 16; ++j) { const unsigned c = xb_ld(&bar[XB_XCNT(j)]); sum += c; cnt += (c > 0u) ? 1u : 0u; mine = (j == x) ? c : mine; }
        if (sum == G) break;
        __builtin_amdgcn_s_sleep(1);
        if ((++sp & 255u) == 0u) { if (xb_ld(&bar[XB_TMO])) break; if (sp > XB_SPIN_CAP) { atomicAdd(&bar[XB_TMO], 1u); break; } }
    }
    nloc = mine > 0u ? mine : 1u; nx = cnt > 0u ? cnt : 1u;
}

__device__ __forceinline__ void xcd_barrier(const XcdBarrier& b) {
    asm volatile("s_waitcnt vmcnt(0)" ::: "memory");
    __syncthreads();
    if (b.wave == 0 && hw_lane() == 0) {
        unsigned* bar = b.bar;
        __builtin_amdgcn_s_waitcnt(0);
        unsigned nloc = b.st[0], nx = b.st[1];
        if (nloc == 0u) { xcd_barrier_complete(bar, b.x, nloc, nx); b.st[0] = nloc; b.st[1] = nx; }
        const unsigned old = xb_add(&bar[XB_XSUB(b.x)], 1u);
        const unsigned gen = old / nloc;
        if (old + 1u == (gen + 1u) * nloc) {
            __builtin_amdgcn_fence(__ATOMIC_RELEASE, "agent");
            asm volatile("s_waitcnt vmcnt(0)" ::: "memory");
            const unsigned og = xb_add(&bar[XB_TOP], 1u);
            const unsigned tg = og / nx;
            if (og + 1u == (tg + 1u) * nx) xb_add(&bar[XB_TOPGEN], 1u);
            else XB_SPIN(xb_ld(&bar[XB_TOPGEN]) == tg, bar);
            __builtin_amdgcn_fence(__ATOMIC_ACQUIRE, "agent");
            xb_add(&bar[XB_XGEN(b.x)], 1u);
            asm volatile("s_waitcnt vmcnt(0)" ::: "memory");
        } else {
            XB_SPIN(xb_ld(&bar[XB_XGEN(b.x)]) == gen, bar);
            __builtin_amdgcn_fence(__ATOMIC_ACQUIRE, "agent");
            asm volatile("s_waitcnt vmcnt(0)" ::: "memory");
        }
    }
    __syncthreads();
}

struct Frame {
    LAS unsigned char* lds;
    volatile LAS unsigned* MISC;
    gu32* ctl;
    int wave;
    int vcu, G;
    const float* in[30]; float* out; unsigned char* ws;
};
enum { IN_X = 0, IN_P, IN_FFN1_NORM, IN_FFN1_WG, IN_FFN1_WU, IN_FFN1_WD, IN_MIX_NORM, IN_WIN, IN_LAM_RE, IN_LAM_IM, IN_LOG_DT, IN_B_RE, IN_B_IM, IN_C_RE, IN_C_IM, IN_S5D, IN_GLU_VAL, IN_GLU_GATE,
       IN_HG_LB, IN_HG_NORM, IN_HG_WOUT, IN_WMERGE, IN_FFN2_NORM, IN_FFN2_WG, IN_FFN2_WU, IN_FFN2_WD, IN_PLE_NORM, IN_PLE_WG, IN_PLE_WP, IN_FINAL_NORM };

__device__ __forceinline__ float wave_sum(float v) {
#pragma unroll
    for (int o = 1; o < 64; o <<= 1) v += __shfl_xor(v, o);
    return v;
}
__device__ __forceinline__ void p0_transpose_item(const float* W, int K, int N, bf16* WT, const float* gain, float scale, int mode, LAS float* scr, int item, int lane) {
    const int nblk = N / 32, kb = item / nblk, nb = item % nblk, k0 = 64 * kb, n0 = 32 * nb;
#pragma unroll 8
    for (int i = 0; i < 32; ++i) { const int kk = 2 * i + (lane >> 5); const float gs = gain ? gain[k0 + kk] * scale : scale; scr[kk * 33 + (lane & 31)] = W[(size_t)(k0 + kk) * N + n0 + (lane & 31)] * gs; }
    LDS_WAIT(); asm volatile("" ::: "memory");
    const int c = lane & 7;
    const int nr0 = (mode == 0) ? n0 : 256 * (n0 >> 7) + (n0 & 127) + (mode == 2 ? 128 : 0);
#pragma unroll
    for (int j = 0; j < 4; ++j) { const int n = (lane >> 3) + 8 * j; const LAS float* s = scr + (8 * c) * 33 + n;
        v4u o; o.x = pk2(s[0 * 33], s[1 * 33]); o.y = pk2(s[2 * 33], s[3 * 33]); o.z = pk2(s[4 * 33], s[5 * 33]); o.w = pk2(s[6 * 33], s[7 * 33]);
        *(GAS v4u*)(WT + (size_t)(nr0 + n) * K + k0 + 8 * c) = o; }
    LDS_WAIT(); asm volatile("" ::: "memory");
}
struct cplx { double re, im; };
__device__ __forceinline__ cplx cmul(cplx a, cplx b) { return {a.re * b.re - a.im * b.im, a.re * b.im + a.im * b.re}; }
__device__ __forceinline__ cplx ldc(const LAS double* p, int i) { cplx r; r.re = p[2 * i]; r.im = p[2 * i + 1]; return r; }
__device__ __forceinline__ void stc(LAS double* p, int i, cplx v) { p[2 * i] = v.re; p[2 * i + 1] = v.im; }

__device__ __forceinline__ void p0_s5_tables(Frame& F, int g, int j) {
    LAS f32x2* LP = (LAS f32x2*)(F.lds); LAS f32x2* BB = (LAS f32x2*)(F.lds + 16896); LAS f32x2* CC = (LAS f32x2*)(F.lds + 16896 + 8192); LAS float* KK = (LAS float*)(F.lds + 16896 + 8192 + 1024);
    const float* lam_re = F.in[IN_LAM_RE] + g * 64; const float* lam_im = F.in[IN_LAM_IM] + g * 64;
    const float* b_re = F.in[IN_B_RE] + g * 1024; const float* b_im = F.in[IN_B_IM] + g * 1024;
    const float* c_re = F.in[IN_C_RE] + g * 1024; const float* c_im = F.in[IN_C_IM] + g * 1024;
    const int tid = F.wave * 64 + hw_lane();
    if (tid < 64) {
        const int p = tid; const double lr = (double)lam_re[p], li = (double)lam_im[p]; const double dt = exp((double)F.in[IN_LOG_DT][g]);
        const double er = exp(lr * dt); const double sn = sin(li * dt), cs = cos(li * dt);
        const cplx lb = {er * cs, er * sn}; cplx pw = {1.0, 0.0};
        for (int k = 0; k <= 32; ++k) { LP[k * 64 + p] = (f32x2){(float)pw.re, (float)pw.im}; if (k == 32 && j == 0) { ((float*)(F.ws + WS_LAMT))[(g * 64 + p) * 2] = (float)pw.re; ((float*)(F.ws + WS_LAMT))[(g * 64 + p) * 2 + 1] = (float)pw.im; } pw = cmul(pw, lb); }
        const double den = lr * lr + li * li; const cplx num = {lb.re - 1.0, lb.im}; const cplx coef = {(num.re * lr + num.im * li) / den, (num.im * lr - num.re * li) / den};
        for (int h = 0; h < 16; ++h) { const cplx b = {(double)b_re[p * 16 + h], (double)b_im[p * 16 + h]}; const cplx bb = cmul(coef, b); BB[p * 16 + h] = (f32x2){(float)bb.re, (float)bb.im}; }
    } else if (tid < 192) { const int e = tid - 64, hol = e >> 6, p = e & 63; CC[e] = (f32x2){c_re[(2 * j + hol) * 64 + p], c_im[(2 * j + hol) * 64 + p]}; }
    LDS_WAIT(); __syncthreads();
    for (int e = tid; e < 32 * 32; e += 512) { const int k = e >> 5, hol = (e >> 4) & 1, hi = e & 15, ho = 2 * j + hol; float s = 0.f;
        for (int p = 0; p < 64; ++p) { const f32x2 c = CC[hol * 64 + p], l = LP[k * 64 + p], bb = BB[p * 16 + hi]; const float tr = l.x * bb.x - l.y * bb.y, ti = l.x * bb.y + l.y * bb.x; s += c.x * tr - c.y * ti; }
        if (k == 0 && ho == hi) s += F.in[IN_S5D][g * 16 + ho];
        KK[e] = s; }
    LDS_WAIT(); __syncthreads();
    bf16* TO = (bf16*)(F.ws + WS_TOEP) + (size_t)g * 768 * 512;
    for (int ch = tid; ch < 64 * 64; ch += 512) { const int rl = ch >> 6, cc = ch & 63, t = rl >> 1, hol = rl & 1, n = t * 16 + 2 * j + hol, s = cc >> 1, hi0 = (cc & 1) * 8; float v[8];
#pragma unroll
        for (int e = 0; e < 8; ++e) v[e] = (s <= t) ? KK[((t - s) * 2 + hol) * 16 + hi0 + e] : 0.f;
        v4u o; o.x = pk2(v[0], v[1]); o.y = pk2(v[2], v[3]); o.z = pk2(v[4], v[5]); o.w = pk2(v[6], v[7]);
        *(GAS v4u*)(TO + (size_t)n * 512 + cc * 8) = o; }
    for (int ch = tid; ch < 32 * 64; ch += 512) { const int rl = ch >> 6, cc = ch & 63, s = cc >> 1, hi0 = (cc & 1) * 8; float v[8]; int n;
        if (rl < 16) { n = 512 + 16 * j + rl; const int p = (n - 512) >> 1, ri = n & 1; const f32x2 l = LP[(31 - s) * 64 + p];
#pragma unroll
            for (int e = 0; e < 8; ++e) { const f32x2 bb = BB[p * 16 + hi0 + e]; v[e] = ri ? (l.x * bb.y + l.y * bb.x) : (l.x * bb.x - l.y * bb.y); } }
        else { n = 640 + 16 * j + (rl - 16);
#pragma unroll
            for (int e = 0; e < 8; ++e) v[e] = 0.f; }
        v4u o; o.x = pk2(v[0], v[1]); o.y = pk2(v[2], v[3]); o.z = pk2(v[4], v[5]); o.w = pk2(v[6], v[7]);
        *(GAS v4u*)(TO + (size_t)n * 512 + cc * 8) = o; }
    bf16* CT = (bf16*)(F.ws + WS_CT) + (size_t)g * 512 * 256;
    for (int ch = tid; ch < 64 * 32; ch += 512) { const int rl = ch >> 5, cc = ch & 31, t = rl >> 1, hol = rl & 1, n = t * 16 + 2 * j + hol; float v[8];
        if (cc < 16) {
#pragma unroll
            for (int e = 0; e < 4; ++e) { const int p = cc * 4 + e; const f32x2 c = CC[hol * 64 + p], l = LP[(t + 1) * 64 + p]; v[2 * e] = c.x * l.x - c.y * l.y; v[2 * e + 1] = -(c.x * l.y + c.y * l.x); } }
        else {
#pragma unroll
            for (int e = 0; e < 8; ++e) v[e] = 0.f; }
        v4u o; o.x = pk2(v[0], v[1]); o.y = pk2(v[2], v[3]); o.z = pk2(v[4], v[5]); o.w = pk2(v[6], v[7]);
        *(GAS v4u*)(CT + (size_t)n * 256 + cc * 8) = o; }
    LDS_WAIT(); __syncthreads();
}

__device__ __forceinline__ void p0_prologue(Frame& F) {
    if (F.vcu < 256) p0_s5_tables(F, F.vcu >> 3, F.vcu & 7);
    const int lane = hw_lane(), tid = F.wave * 64 + lane;
    if (F.vcu == 32 && tid < 256) {
        const float* hb = F.in[IN_HG_LB]; float* LB = (float*)(F.ws + WS_LB);
        for (int c = tid; c < 1024; c += 256) { const float a0 = hb[c], a1 = hb[1024 + c]; LB[c] = 1.f / (1.f + expf(a1 - a0)); }
    }
    LAS float* scr = (LAS float*)(F.lds + RING_OFF + F.wave * 16384);
    const int gw = F.vcu * NWAVES + F.wave, NGW = F.G * NWAVES;
    int base = 0;
#define P0_W(INW, KK_, NN_, OFF, GAINP, SCALE, MODE) { constexpr int ni = ((KK_) / 64) * ((NN_) / 32); int first = (gw - base) % NGW; if (first < 0) first += NGW; \
        for (int it = first; it < ni; it += NGW) p0_transpose_item(F.in[INW], KK_, NN_, (bf16*)(F.ws + (OFF)), GAINP, SCALE, MODE, scr, it, lane); base += ni; }
    P0_W(IN_FFN1_WG, 1024, 2816, WS_W1GU, F.in[IN_FFN1_NORM], 1.f, 1) P0_W(IN_FFN1_WU, 1024, 2816, WS_W1GU, F.in[IN_FFN1_NORM], 1.f, 2) P0_W(IN_FFN1_WD, 2816, 1024, WS_W1D, nullptr, 0.5f, 0)
    P0_W(IN_WIN, 1024, 6656, WS_WIN, F.in[IN_MIX_NORM], 1.f, 0) P0_W(IN_GLU_VAL, 512, 1024, WS_WGLU, nullptr, 1.f, 1) P0_W(IN_GLU_GATE, 512, 1024, WS_WGLU, nullptr, 1.f, 2)
    P0_W(IN_HG_WOUT, 1024, 1024, WS_WHG, nullptr, 1.f, 0) P0_W(IN_WMERGE, 1024, 1024, WS_WM, nullptr, 1.f, 0)
    P0_W(IN_FFN2_WG, 1024, 2816, WS_W2GU, F.in[IN_FFN2_NORM], 1.f, 1) P0_W(IN_FFN2_WU, 1024, 2816, WS_W2GU, F.in[IN_FFN2_NORM], 1.f, 2) P0_W(IN_FFN2_WD, 2816, 1024, WS_W2D, nullptr, 0.5f, 0)
    P0_W(IN_PLE_WG, 1024, 1024, WS_WPG, F.in[IN_PLE_NORM], 1.f, 0) P0_W(IN_PLE_WP, 256, 1024, WS_WPP, nullptr, 1.f, 0)
#undef P0_W
    const float* x = F.in[IN_X]; bf16* XB = (bf16*)(F.ws + WS_XB); float* RS = (float*)(F.ws + WS_RS);
    for (int m = gw; m < M_TOK; m += NGW) { const GAS f32x4* xr = (const GAS f32x4*)(x + (size_t)m * DM) + lane; f32x4 v[4]; float s = 0.f;
#pragma unroll
        for (int j = 0; j < 4; ++j) { v[j] = xr[64 * j]; s += (v[j].x * v[j].x + v[j].y * v[j].y) + (v[j].z * v[j].z + v[j].w * v[j].w); }
        s = wave_sum(s);
        GAS v2u* o8 = (GAS v2u*)(XB + (size_t)m * DM) + lane;
#pragma unroll
        for (int j = 0; j < 4; ++j) { v2u w; w.x = pk2(v[j].x, v[j].y); w.y = pk2(v[j].z, v[j].w); o8[64 * j] = w; }
        if (lane == 0) *(f32x4*)(RS + (size_t)m * 4) = (f32x4){s, 0.f, 0.f, 0.f}; }
    const float* pin = F.in[IN_P]; bf16* PB = (bf16*)(F.ws + WS_PB);
    for (size_t i = (size_t)gw * 64 + lane; i < (size_t)M_TOK * 256 / 4; i += (size_t)NGW * 64) { const f32x4 v = ((const GAS f32x4*)pin)[i]; v2u w; w.x = pk2(v.x, v.y); w.y = pk2(v.z, v.w); ((GAS v2u*)PB)[i] = w; }
}

__device__ __forceinline__ void s5_scan_phase(Frame& F) {
    const int idx = blockIdx.x * 512 + F.wave * 64 + hw_lane(); if (idx >= 32 * NBATCH * 64) return;
    const int g = idx >> 8, b = (idx >> 6) & 3, p = idx & 63;
    const float* XL = (const float*)(F.ws + WS_XL) + ((size_t)(g * S5ROWS + b * S5NC)) * 128 + 2 * p; unsigned* XP = (unsigned*)(F.ws + WS_XP) + ((size_t)(g * S5ROWS + b * S5NC)) * 128 + p;
    const f32x2 lt = *(const f32x2*)((const float*)(F.ws + WS_LAMT) + (g * 64 + p) * 2);
    float xr = 0.f, xi = 0.f;
#pragma unroll 8
    for (int c = 0; c < S5NC; ++c) { const f32x2 l = *(const f32x2*)(XL + (size_t)c * 128);
        XP[(size_t)c * 128] = pk2(xr, xi); XP[(size_t)c * 128 + 64] = 0u;
        const float nr = lt.x * xr - lt.y * xi + l.x, ni = lt.x * xi + lt.y * xr + l.y; xr = nr; xi = ni; }
}

__device__ __forceinline__ void final_norm_phase(Frame& F) {
    const int gw = F.vcu * NWAVES + F.wave, NGW = F.G * NWAVES; const float* RS2 = (const float*)(F.ws + WS_RS2); const float* fn = F.in[IN_FINAL_NORM]; const int lane = hw_lane();
    f32x4 gn[4];
#pragma unroll
    for (int j = 0; j < 4; ++j) gn[j] = ((const f32x4*)fn)[lane + 64 * j];
    for (int m = gw; m < M_TOK; m += NGW) { const f32x4 p = *(const f32x4*)(RS2 + (size_t)m * 4); const float r = 1.0f / sqrtf(((p.x + p.y) + (p.z + p.w)) * (1.0f / 1024.0f) + NORM_EPS);
        GAS f32x4* o = (GAS f32x4*)(F.out + (size_t)m * DM) + lane;
#pragma unroll
        for (int j = 0; j < 4; ++j) { f32x4 v = o[64 * j]; v = v * r * gn[j]; o[64 * j] = v; } }
}

constexpr int PA_GC = 0, PA_QT = 32768, PA_KT = PA_QT + 17408, PA_VV = PA_KT + 17408, PA_P = PA_VV + 17408, PA_TOT = PA_P + 9216, PA_GL = PA_TOT + 2048;
static_assert(PA_GL + 512 <= RING_BYTES, "hgrn pass A lds");
__device__ __forceinline__ float h2f(unsigned short h) { return (float)__builtin_bit_cast(_Float16, h); }
__device__ __forceinline__ void tr_frag2(unsigned addr, bf16x8& f0, bf16x8& f1) {
    s16x4 a, b, c, d;
    asm volatile("ds_read_b64_tr_b16 %0, %4\n\tds_read_b64_tr_b16 %1, %4 offset:1088\n\tds_read_b64_tr_b16 %2, %4 offset:8704\n\tds_read_b64_tr_b16 %3, %4 offset:9792\n\ts_waitcnt lgkmcnt(0)"
                 : "=&v"(a), "=&v"(b), "=&v"(c), "=&v"(d) : "v"(addr) : "memory");
    f0 = (bf16x8){a[0], a[1], a[2], a[3], b[0], b[1], b[2], b[3]}; f1 = (bf16x8){c[0], c[1], c[2], c[3], d[0], d[1], d[2], d[3]};
}
__device__ __forceinline__ void hgrn_pass_a(Frame& F) {
    const int lane = hw_lane(), w = F.wave, tid = w * 64 + lane, l15 = lane & 15, lg = lane >> 4;
    LAS unsigned char* L = F.lds;
    LAS float* GC = (LAS float*)(L + PA_GC); LAS float* TOT = (LAS float*)(L + PA_TOT); LAS float* GL = (LAS float*)(L + PA_GL);
    bf16* Qg = (bf16*)(F.ws + WS_Q); unsigned short* Gg = (unsigned short*)(F.ws + WS_G16); bf16* Ig = (bf16*)(F.ws + WS_I); bf16* OI = (bf16*)(F.ws + WS_TOEP); float* DF = (float*)(F.ws + WS_DF);
    const int s_ = tid >> 3, kb = tid & 7, ck = tid & 127, cgp = tid >> 7;
    const size_t laneoff = (size_t)lg * 1024 + l15 * 8;
    const unsigned trbase = (unsigned)(8 * lg + (l15 >> 2)) * 272u + (unsigned)(l15 & 3) * 8u;
    int u = F.vcu;
    v4u q0, q1, g0, g1, i0, i1;
    if (u < 2048) { const int bh = u >> 6, c = u & 63; const size_t off = ((size_t)(bh >> 3) * SEQ + c * 64 + s_) * DM + (bh & 7) * 128 + kb * 16;
        q0 = *(const GAS v4u*)(Qg + off); q1 = *(const GAS v4u*)(Qg + off + 8); g0 = *(const GAS v4u*)(Gg + off); g1 = *(const GAS v4u*)(Gg + off + 8); i0 = *(const GAS v4u*)(Ig + off); i1 = *(const GAS v4u*)(Ig + off + 8); }
#pragma unroll 1
    for (; u < 2048; u += F.G) {
        const int bh = u >> 6, c = u & 63; const size_t E0 = ((size_t)(bh >> 3) * SEQ + c * 64) * DM + (bh & 7) * 128;
        float qv[16], gv[16];
        { const unsigned qa[8] = {q0.x, q0.y, q0.z, q0.w, q1.x, q1.y, q1.z, q1.w}, ga[8] = {g0.x, g0.y, g0.z, g0.w, g1.x, g1.y, g1.z, g1.w};
#pragma unroll
          for (int j = 0; j < 8; ++j) { qv[2 * j] = bflo(qa[j]); qv[2 * j + 1] = bfhi(qa[j]); gv[2 * j] = h2f((unsigned short)(ga[j] & 0xffffu)); gv[2 * j + 1] = h2f((unsigned short)(ga[j] >> 16)); } }
#pragma unroll
        for (int j = 0; j < 4; ++j) *(LAS f32x4*)(GC + s_ * 128 + kb * 16 + 4 * j) = (f32x4){gv[4 * j], gv[4 * j + 1], gv[4 * j + 2], gv[4 * j + 3]};
        *(LAS v4u*)(L + PA_VV + s_ * 272 + kb * 32) = i0; *(LAS v4u*)(L + PA_VV + s_ * 272 + kb * 32 + 16) = i1;
        { const int un = u + F.G; if (un < 2048) { const int bh2 = un >> 6, c2 = un & 63; const size_t off = ((size_t)(bh2 >> 3) * SEQ + c2 * 64 + s_) * DM + (bh2 & 7) * 128 + kb * 16;
            q0 = *(const GAS v4u*)(Qg + off); q1 = *(const GAS v4u*)(Qg + off + 8); g0 = *(const GAS v4u*)(Gg + off); g1 = *(const GAS v4u*)(Gg + off + 8); i0 = *(const GAS v4u*)(Ig + off); i1 = *(const GAS v4u*)(Ig + off + 8); } }
        LDS_WAIT(); __builtin_amdgcn_s_barrier(); asm volatile("" ::: "memory");
        { float loc[16]; float run = 0.f;
#pragma unroll
          for (int j = 0; j < 16; ++j) { run += GC[(cgp * 16 + j) * 128 + ck]; loc[j] = run; }
          TOT[cgp * 128 + ck] = run;
          LDS_WAIT(); __builtin_amdgcn_s_barrier(); asm volatile("" ::: "memory");
          float off = 0.f;
#pragma unroll
          for (int gg = 0; gg < 3; ++gg) off += (gg < cgp) ? TOT[gg * 128 + ck] : 0.f;
#pragma unroll
          for (int j = 0; j < 16; ++j) GC[(cgp * 16 + j) * 128 + ck] = loc[j] + off;
          if (cgp == 3) { const float gl = loc[15] + off; GL[ck] = gl; DF[(size_t)u * 128 + ck] = __expf(gl); } }
        LDS_WAIT(); __builtin_amdgcn_s_barrier(); asm volatile("" ::: "memory");
        { float qt[16], kt[16];
#pragma unroll
          for (int j = 0; j < 16; ++j) { const float d = GC[s_ * 128 + kb * 16 + j] - GL[kb * 16 + j]; const float E = __expf(d), Ei = __expf(-d); const float kk = 1.f - __expf(gv[j]); qt[j] = qv[j] * E; kt[j] = kk * Ei; }
          v4u a, bq;
          a.x = pk2(qt[0], qt[1]); a.y = pk2(qt[2], qt[3]); a.z = pk2(qt[4], qt[5]); a.w = pk2(qt[6], qt[7]); bq.x = pk2(qt[8], qt[9]); bq.y = pk2(qt[10], qt[11]); bq.z = pk2(qt[12], qt[13]); bq.w = pk2(qt[14], qt[15]);
          *(LAS v4u*)(L + PA_QT + s_ * 272 + kb * 32) = a; *(LAS v4u*)(L + PA_QT + s_ * 272 + kb * 32 + 16) = bq;
          a.x = pk2(kt[0], kt[1]); a.y = pk2(kt[2], kt[3]); a.z = pk2(kt[4], kt[5]); a.w = pk2(kt[6], kt[7]); bq.x = pk2(kt[8], kt[9]); bq.y = pk2(kt[10], kt[11]); bq.z = pk2(kt[12], kt[13]); bq.w = pk2(kt[14], kt[15]);
          *(LAS v4u*)(L + PA_KT + s_ * 272 + kb * 32) = a; *(LAS v4u*)(L + PA_KT + s_ * 272 + kb * 32 + 16) = bq; }
        LDS_WAIT(); __builtin_amdgcn_s_barrier(); asm volatile("" ::: "memory");
        { const int tm = w >> 1;
#pragma unroll
          for (int jn = 0; jn < 2; ++jn) { const int tn = 2 * (w & 1) + jn; f32x4 sc = (f32x4){0.f, 0.f, 0.f, 0.f};
            if (tn <= tm) {
#pragma unroll
                for (int ks = 0; ks < 4; ++ks) { const bf16x8 a = *(const LAS bf16x8*)(L + PA_KT + (16 * tn + l15) * 272 + (32 * ks + 8 * lg) * 2); const bf16x8 bb = *(const LAS bf16x8*)(L + PA_QT + (16 * tm + l15) * 272 + (32 * ks + 8 * lg) * 2);
                    sc = __builtin_amdgcn_mfma_f32_16x16x32_bf16(a, bb, sc, 0, 0, 0); } }
            const int t = 16 * tm + l15, s0 = 16 * tn + 4 * lg; v2u pw; pw.x = pk2(s0 <= t ? sc[0] : 0.f, s0 + 1 <= t ? sc[1] : 0.f); pw.y = pk2(s0 + 2 <= t ? sc[2] : 0.f, s0 + 3 <= t ? sc[3] : 0.f);
            *(LAS v2u*)(L + PA_P + t * 144 + s0 * 2) = pw; } }
        bf16x8 vf0, vf1, kf0, kf1;
        tr_frag2((unsigned)(size_t)(L + PA_VV) + trbase + (unsigned)w * 32u, vf0, vf1);
        tr_frag2((unsigned)(size_t)(L + PA_KT) + trbase + (unsigned)w * 32u, kf0, kf1);
        *(GAS bf16x8*)(Ig + E0 + (size_t)(2 * w) * 4096 + laneoff) = vf0; *(GAS bf16x8*)(Ig + E0 + (size_t)(2 * w + 1) * 4096 + laneoff) = vf1;
        *(GAS bf16x8*)(Gg + E0 + (size_t)(2 * w) * 4096 + laneoff) = kf0; *(GAS bf16x8*)(Gg + E0 + (size_t)(2 * w + 1) * 4096 + laneoff) = kf1;
#pragma unroll
        for (int j = 0; j < 2; ++j) { const int f = 2 * w + j, tmq = f >> 2, iq = f & 3; const v2u lo = *(const LAS v2u*)(L + PA_QT + (16 * tmq + l15) * 272 + (32 * iq + 4 * lg) * 2), hi = *(const LAS v2u*)(L + PA_QT + (16 * tmq + l15) * 272 + (32 * iq + 16 + 4 * lg) * 2);
            v4u o; o.x = lo.x; o.y = lo.y; o.z = hi.x; o.w = hi.y; *(GAS v4u*)(Qg + E0 + (size_t)f * 4096 + laneoff) = o; }
        LDS_WAIT(); __builtin_amdgcn_s_barrier(); asm volatile("" ::: "memory");
#pragma unroll
        for (int tm = 0; tm < 4; ++tm) { f32x4 a4 = (f32x4){0.f, 0.f, 0.f, 0.f};
            { const bf16x8 pf = *(const LAS bf16x8*)(L + PA_P + (16 * tm + l15) * 144 + (8 * lg) * 2); a4 = __builtin_amdgcn_mfma_f32_16x16x32_bf16(vf0, pf, a4, 0, 0, 0); }
            if (tm >= 2) { const bf16x8 pf = *(const LAS bf16x8*)(L + PA_P + (16 * tm + l15) * 144 + (32 + 8 * lg) * 2); a4 = __builtin_amdgcn_mfma_f32_16x16x32_bf16(vf1, pf, a4, 0, 0, 0); }
            v2u ow; ow.x = pk2(a4[0], a4[1]); ow.y = pk2(a4[2], a4[3]); *(GAS v2u*)(OI + E0 + (size_t)(16 * tm + l15) * DM + 16 * w + 4 * lg) = ow; }
    }
}

constexpr int PB_QF = 0, PB_KTF = 16384, PB_VTF = 32768, PB_OI = 34816, PB_DF = 36864, PB_SLOT = 37376, PB_NSLOT = 4;
static_assert(PB_NSLOT * PB_SLOT <= LDSCTL_OFF, "hgrn pass B lds");
__device__ __forceinline__ void hgrn_pass_b(Frame& F) {
    const int bh = F.vcu >> 3; if (bh >= 32) return;
    const int lane = hw_lane(), l15 = lane & 15, lg = lane >> 4, w = F.vcu & 7, hw = F.wave, b = bh >> 3, h = bh & 7;
    LAS unsigned char* L = F.lds;
    const bf16* Qg = (const bf16*)(F.ws + WS_Q); const bf16* Kg = (const bf16*)(F.ws + WS_G16); const bf16* Vg = (const bf16*)(F.ws + WS_I); bf16* OI = (bf16*)(F.ws + WS_TOEP);
    const float* DF = (const float*)(F.ws + WS_DF); float* RPART = (float*)(F.ws + WS_RPART);
    const size_t laneoff = (size_t)lg * 1024 + l15 * 8;
    const size_t Eb = ((size_t)b * SEQ) * DM + h * 128;
    f32x4 S[8];
#pragma unroll
    for (int i = 0; i < 8; ++i) S[i] = (f32x4){0.f, 0.f, 0.f, 0.f};
#define PB_ISSUE(cc, SLOT) do { const int c_ = (cc) < SEQ / 64 ? (cc) : SEQ / 64 - 1; const size_t E0_ = Eb + (size_t)c_ * 64 * DM; LAS unsigned char* sl_ = L + (SLOT) * PB_SLOT; \
        _Pragma("unroll") for (int f_ = 0; f_ < 2; ++f_) { \
            __builtin_amdgcn_global_load_lds((const unsigned*)(Qg + E0_ + (size_t)(2 * hw + f_) * 4096 + laneoff), (LAS unsigned*)(sl_ + PB_QF + (2 * hw + f_) * 1024), 16, 0, 0); \
            __builtin_amdgcn_global_load_lds((const unsigned*)(Kg + E0_ + (size_t)(2 * hw + f_) * 4096 + laneoff), (LAS unsigned*)(sl_ + PB_KTF + (2 * hw + f_) * 1024), 16, 0, 0); } \
        if (hw < 2) __builtin_amdgcn_global_load_lds((const unsigned*)(Vg + E0_ + (size_t)(2 * w + hw) * 4096 + laneoff), (LAS unsigned*)(sl_ + PB_VTF + hw * 1024), 16, 0, 0); \
        else if (hw < 4) __builtin_amdgcn_global_load_lds((const unsigned*)(OI + E0_ + (size_t)(32 * (hw - 2) + (lane >> 1)) * DM + 16 * w + (lane & 1) * 8), (LAS unsigned*)(sl_ + PB_OI + (hw - 2) * 1024), 16, 0, 0); \
        else if (hw < 6) __builtin_amdgcn_global_load_lds((const unsigned*)(DF + ((size_t)bh * 64 + c_) * 128 + (hw - 4) * 64 + lane), (LAS unsigned*)(sl_ + PB_DF + (hw - 4) * 256), 4, 0, 0); } while (0)
    PB_ISSUE(0, 0); PB_ISSUE(1, 1); PB_ISSUE(2, 2);
#define PB_CHUNK(c, SLOT) do { \
        if (hw == 0) { if ((c) == 0) asm volatile("s_waitcnt vmcnt(10)" ::: "memory"); else asm volatile("s_waitcnt vmcnt(18)" ::: "memory"); }     \
        else if (hw < 6) asm volatile("s_waitcnt vmcnt(10)" ::: "memory"); else asm volatile("s_waitcnt vmcnt(8)" ::: "memory"); \
        asm volatile("s_waitcnt lgkmcnt(0)" ::: "memory"); \
        __builtin_amdgcn_s_barrier(); asm volatile("" ::: "memory");            \
        __builtin_amdgcn_sched_barrier(0); \
        PB_ISSUE((c) + 3, ((SLOT) + 3) & 3); \
        if (hw == 0) { \
        LAS unsigned char* sl = L + (SLOT) * PB_SLOT; \
        f32x4 acc[4]; \
        _Pragma("unroll") for (int tm = 0; tm < 4; ++tm) { const v2u oi = *(const LAS v2u*)(sl + PB_OI + (16 * tm + l15) * 32 + lg * 8); acc[tm] = (f32x4){bflo(oi.x), bfhi(oi.x), bflo(oi.y), bfhi(oi.y)}; } \
        bf16x8 Sf[4]; \
        _Pragma("unroll") for (int kt = 0; kt < 8; ++kt) { const f32x4 d = *(const LAS f32x4*)(sl + PB_DF + (16 * kt + 4 * lg) * 4); S[kt] = S[kt] * d; } \
        _Pragma("unroll") for (int i = 0; i < 4; ++i) { v4u u_; u_.x = pk2(S[2 * i][0], S[2 * i][1]); u_.y = pk2(S[2 * i][2], S[2 * i][3]); u_.z = pk2(S[2 * i + 1][0], S[2 * i + 1][1]); u_.w = pk2(S[2 * i + 1][2], S[2 * i + 1][3]); Sf[i] = __builtin_bit_cast(bf16x8, u_); } \
        _Pragma("unroll") for (int tm = 0; tm < 4; ++tm) \
            _Pragma("unroll") for (int i = 0; i < 4; ++i) { const bf16x8 qf = *(const LAS bf16x8*)(sl + PB_QF + (tm * 4 + i) * 1024 + lane * 16); acc[tm] = __builtin_amdgcn_mfma_f32_16x16x32_bf16(Sf[i], qf, acc[tm], 0, 0, 0); } \
        { const bf16x8 v0 = *(const LAS bf16x8*)(sl + PB_VTF + lane * 16), v1 = *(const LAS bf16x8*)(sl + PB_VTF + 1024 + lane * 16); \
          _Pragma("unroll") for (int kt = 0; kt < 8; ++kt) { const bf16x8 k0 = *(const LAS bf16x8*)(sl + PB_KTF + (2 * kt) * 1024 + lane * 16), k1 = *(const LAS bf16x8*)(sl + PB_KTF + (2 * kt + 1) * 1024 + lane * 16); \
              S[kt] = __builtin_amdgcn_mfma_f32_16x16x32_bf16(k0, v0, S[kt], 0, 0, 0); S[kt] = __builtin_amdgcn_mfma_f32_16x16x32_bf16(k1, v1, S[kt], 0, 0, 0); } } \
        _Pragma("unroll") for (int tm = 0; tm < 4; ++tm) { const f32x4 o = acc[tm]; const size_t row = (size_t)b * SEQ + (c) * 64 + 16 * tm + l15; v2u ow; ow.x = pk2(o[0], o[1]); ow.y = pk2(o[2], o[3]); \
            *(GAS v2u*)(OI + row * DM + h * 128 + 16 * w + 4 * lg) = ow; \
            float s = (o[0] * o[0] + o[1] * o[1]) + (o[2] * o[2] + o[3] * o[3]); s += __shfl_xor(s, 16); s += __shfl_xor(s, 32); \
            if (lg == 0) RPART[(row * 8 + h) * 8 + w] = s; } } } while (0)
#pragma unroll 1
    for (int c4 = 0; c4 < SEQ / 64; c4 += 4) { PB_CHUNK(c4, 0); PB_CHUNK(c4 + 1, 1); PB_CHUNK(c4 + 2, 2); PB_CHUNK(c4 + 3, 3); }
    asm volatile("s_waitcnt vmcnt(0) lgkmcnt(0)" ::: "memory");
#undef PB_CHUNK
#undef PB_ISSUE
}

struct Args { const float* in[30]; float* out; unsigned char* ws; int ph_lo, ph_hi; };
__global__ void __launch_bounds__(NWAVES * 64, 2) blk_fwd(Args args) {
    extern __shared__ __attribute__((aligned(16))) unsigned char lds[];
    Frame F;
    F.lds = (LAS unsigned char*)lds;
    F.MISC = (volatile LAS unsigned*)(F.lds + MISC_OFF);
    F.wave = __builtin_amdgcn_readfirstlane((int)threadIdx.x >> 6);
    F.G = gridDim.x; { const int bx = blockIdx.x; F.vcu = (F.G % 8 == 0) ? (bx % 8) * (F.G / 8) + bx / 8 : bx; }
    F.ws = args.ws; F.out = args.out; F.ctl = (gu32*)(args.ws + WS_CTL);
#pragma unroll
    for (int i = 0; i < 30; ++i) F.in[i] = args.in[i];
    for (int u = (int)threadIdx.x; u < (LDS_BYTES - LDSCTL_OFF) / 4; u += NWAVES * 64) ((LAS unsigned*)(F.lds + LDSCTL_OFF))[u] = 0u;
    __syncthreads();
    XcdBarrier bar; bar.bar = (unsigned*)(F.ctl + CW_BAR); bar.x = 0; bar.st = nullptr; bar.wave = F.wave;
    if (N_LAUNCHES == 1) { bar = xcd_barrier_post((unsigned*)(F.ctl + CW_BAR), F.MISC + 8); bar.wave = F.wave; }
    const int lo = args.ph_lo, hi = args.ph_hi;
#ifndef PROBE_REP
#define PROBE_REP -1
#endif
#ifndef PHASE_MASK
#define PHASE_MASK 0x7ffff
#endif
#define IN(k) ((((PHASE_MASK) >> (k)) & 1) && lo <= (k) && (k) < hi)
#define SEAM(k) do { if (IN(k) && IN((k) + 1)) xcd_barrier(bar); } while (0)
    using namespace pg8;
    bf16_t* const XB = (bf16_t*)(F.ws + WS_XB); float* const RS = (float*)(F.ws + WS_RS); float* const RS2 = (float*)(F.ws + WS_RS2);
    bf16_t* const HID = (bf16_t*)(F.ws + WS_HID); bf16_t* const WIN = (bf16_t*)(F.ws + WS_WIN);
    const int cid = (int)blockIdx.x;

    if (IN(0)) { if (PROBE_REP == 0) { p0_prologue(F); xcd_barrier(bar); } p0_prologue(F); } SEAM(0);
    if (IN(1)) { Gemm g{XB, (const bf16_t*)(F.ws + WS_W1GU), M_TOK, 2 * FF, DM}; StaticOrder S; S.init(M_TOK, 2 * FF, F.G, cid); EpiSwiglu E{HID, RS};
        gemm_phase<EpiSwiglu, StaticOrder, true, true>(F.lds + RING_OFF, g, S, E, F.wave); } SEAM(1);
    if (IN(2)) { Gemm g{HID, (const bf16_t*)(F.ws + WS_W1D), M_TOK, DM, FF}; StaticOrder S; S.init(M_TOK, DM, F.G, cid); EpiResid E{F.in[IN_X], XB, RS};
        gemm_phase<EpiResid, StaticOrder, false, true>(F.lds + RING_OFF, g, S, E, F.wave); } SEAM(2);
#define MK_EP(off) EpiProj EP{off, RS, (bf16_t*)(F.ws + WS_S5IN), (bf16_t*)(F.ws + WS_Q), (unsigned short*)(F.ws + WS_G16), (bf16_t*)(F.ws + WS_I), (bf16_t*)(F.ws + WS_TOEP), (const float*)(F.ws + WS_RPART), F.in[IN_HG_NORM], \
               (bf16_t*)(F.ws + WS_G16), (bf16_t*)(F.ws + WS_I), (const float*)(F.ws + WS_LB)}
    if (IN(3)) { Gemm g{XB, WIN, M_TOK, 512, DM}; StaticOrder S; S.init(M_TOK, 512, F.G, cid); MK_EP(0);
        gemm_phase<EpiProj, StaticOrder, true, true>(F.lds + RING_OFF, g, S, EP, F.wave); } SEAM(3);
    if (IN(4)) { Gemm g{(const bf16_t*)(F.ws + WS_S5IN), (const bf16_t*)(F.ws + WS_TOEP), 32 * S5ROWS, 32 * 768, 512}; BatchOrder S; S.init(32, 2, 3, F.G, cid); EpiS5a E{(bf16_t*)(F.ws + WS_YS5), (float*)(F.ws + WS_XL)};
        gemm_phase<EpiS5a, BatchOrder, true, true>(F.lds + RING_OFF, g, S, E, F.wave); } SEAM(4);
    if (IN(5)) { if (PROBE_REP == 5) { s5_scan_phase(F); xcd_barrier(bar); } s5_scan_phase(F); } SEAM(5);
    if (IN(6)) { Gemm g{(const bf16_t*)(F.ws + WS_XP), (const bf16_t*)(F.ws + WS_CT), 32 * S5ROWS, 32 * 512, 256}; BatchOrder S; S.init(32, 2, 2, F.G, cid); EpiS5b E{(bf16_t*)(F.ws + WS_YS5)};
        gemm_phase<EpiS5b, BatchOrder, true, true>(F.lds + RING_OFF, g, S, E, F.wave); } SEAM(6);
    if (IN(7)) { Gemm g{XB, WIN + (size_t)512 * DM, M_TOK, 3072, DM}; StaticOrder S; S.init(M_TOK, 3072, F.G, cid); MK_EP(2);
        gemm_phase<EpiProj, StaticOrder, true, true>(F.lds + RING_OFF, g, S, EP, F.wave); } SEAM(7);
    if (IN(8)) { hgrn_pass_a(F); } SEAM(8);
    if (IN(9)) { hgrn_pass_b(F); } SEAM(9);
    if (IN(10)) { Gemm g{XB, WIN + (size_t)3584 * DM, M_TOK, 3072, DM}; StaticOrder S; S.init(M_TOK, 3072, F.G, cid); MK_EP(14);
        gemm_phase<EpiProj, StaticOrder, true, true>(F.lds + RING_OFF, g, S, EP, F.wave); } SEAM(10);
    if (IN(11)) { Gemm g{(const bf16_t*)(F.ws + WS_YS5), (const bf16_t*)(F.ws + WS_WGLU), M_TOK, 2048, 512}; StaticOrder S; S.init(M_TOK, 2048, F.G, cid); EpiGlu E{(bf16_t*)(F.ws + WS_G16)};
        gemm_phase<EpiGlu, StaticOrder, true, true>(F.lds + RING_OFF, g, S, E, F.wave); } SEAM(11);
    if (IN(12)) { Gemm g{(const bf16_t*)(F.ws + WS_TOEP), (const bf16_t*)(F.ws + WS_WHG), M_TOK, DM, DM}; StaticOrder S; S.init(M_TOK, DM, F.G, cid); EpiHgOut E{(bf16_t*)(F.ws + WS_G16), (const bf16_t*)(F.ws + WS_I)};
        gemm_phase<EpiHgOut, StaticOrder, true, true>(F.lds + RING_OFF, g, S, E, F.wave); } SEAM(12);
    if (IN(13)) { Gemm g{(const bf16_t*)(F.ws + WS_G16), (const bf16_t*)(F.ws + WS_WM), M_TOK, DM, DM}; StaticOrder S; S.init(M_TOK, DM, F.G, cid); EpiResid E{nullptr, XB, RS};
        gemm_phase<EpiResid, StaticOrder, false, true>(F.lds + RING_OFF, g, S, E, F.wave); } SEAM(13);
    if (IN(14)) { Gemm g{XB, (const bf16_t*)(F.ws + WS_W2GU), M_TOK, 2 * FF, DM}; StaticOrder S; S.init(M_TOK, 2 * FF, F.G, cid); EpiSwiglu E{HID, RS};
        gemm_phase<EpiSwiglu, StaticOrder, true, true>(F.lds + RING_OFF, g, S, E, F.wave); } SEAM(14);
    if (IN(15)) { Gemm g{HID, (const bf16_t*)(F.ws + WS_W2D), M_TOK, DM, FF}; StaticOrder S; S.init(M_TOK, DM, F.G, cid); EpiResid E{nullptr, XB, RS};
        gemm_phase<EpiResid, StaticOrder, false, true>(F.lds + RING_OFF, g, S, E, F.wave); } SEAM(15);
    if (IN(16)) { Gemm g{(const bf16_t*)(F.ws + WS_PB), (const bf16_t*)(F.ws + WS_WPP), M_TOK, DM, 256}; StaticOrder S; S.init(M_TOK, DM, F.G, cid); EpiPlain E{(bf16_t*)(F.ws + WS_PP), DM};
        gemm_phase<EpiPlain, StaticOrder, true, true>(F.lds + RING_OFF, g, S, E, F.wave); } SEAM(16);
    if (IN(17)) { Gemm g{XB, (const bf16_t*)(F.ws + WS_WPG), M_TOK, DM, DM}; StaticOrder S; S.init(M_TOK, DM, F.G, cid); EpiPle E{F.out, XB, (const bf16_t*)(F.ws + WS_PP), RS, RS2};
        gemm_phase<EpiPle, StaticOrder, false, true>(F.lds + RING_OFF, g, S, E, F.wave); } SEAM(17);
    if (IN(18)) { final_norm_phase(F); }
#undef IN
#undef SEAM
}

extern "C" void kernel_launch(void* const* d_in, const int* in_sizes, int n_in, void* d_out, int out_size, void* d_ws, size_t ws_size, hipStream_t stream) {
    static int grid = 0;
    if (grid == 0) {
        if (n_in != 30 || in_sizes[0] != M_TOK * DM || out_size != M_TOK * DM || ws_size < WS_END) { fprintf(stderr, "kernel_launch: unexpected shapes (n_in %d, in0 %d, out %d, ws %zu)\n", n_in, n_in > 0 ? in_sizes[0] : -1, out_size, ws_size); grid = -1; return; }
        int dev = 0, cus = 0, per_cu = 0;
        if (hipGetDevice(&dev) != hipSuccess || hipDeviceGetAttribute(&cus, hipDeviceAttributeMultiprocessorCount, dev) != hipSuccess) { grid = -1; return; }
        if (hipFuncSetAttribute((const void*)blk_fwd, hipFuncAttributeMaxDynamicSharedMemorySize, LDS_BYTES) != hipSuccess) { fprintf(stderr, "kernel_launch: hipFuncSetAttribute failed\n"); grid = -1; return; }
        if (hipOccupancyMaxActiveBlocksPerMultiprocessor(&per_cu, (const void*)blk_fwd, NWAVES * 64, LDS_BYTES) != hipSuccess || per_cu < 1) { fprintf(stderr, "kernel_launch: occupancy query says %d blocks per CU\n", per_cu); per_cu = 1; }
        (void)hipGetLastError();
        grid = cus;
        if (grid != 256) fprintf(stderr, "kernel_launch: %d CUs; the N = 1024 residual phases need a 256-workgroup grid\n", grid);
    }
    if (grid < 0) return;
    (void)hipMemsetAsync((char*)d_ws + WS_CTL, 0, CTL_ZERO_BYTES, stream);
    Args a{};
    for (int i = 0; i < 30; ++i) a.in[i] = (const float*)d_in[i];
    a.out = (float*)d_out; a.ws = (unsigned char*)d_ws;
    if (N_LAUNCHES == 1) {
        a.ph_lo = 0; a.ph_hi = NPHASE;
        void* kargs[] = {&a};
        hipError_t e = hipLaunchCooperativeKernel((const void*)blk_fwd, dim3(grid), dim3(NWAVES * 64), kargs, LDS_BYTES, stream);
        if (e != hipSuccess) { fprintf(stderr, "kernel_launch: cooperative launch failed: %s; plain launch instead\n", hipGetErrorString(e)); (void)hipGetLastError(); hipLaunchKernelGGL(blk_fwd, dim3(grid), dim3(NWAVES * 64), LDS_BYTES, stream, a); }
    } else {
        for (int li = 0; li < NPHASE; ++li) { a.ph_lo = li; a.ph_hi = li + 1; hipLaunchKernelGGL(blk_fwd, dim3(grid), dim3(NWAVES * 64), LDS_BYTES, stream, a); }
    }
}
```
